# Optimizing an MI355X kernel written in HIP

```python
import jax, jax.numpy as jnp
from jax import lax
import numpy as np

D_MODEL = 1024
BATCH = 8
SEQ = 2048
DEPTH = 1

PLE_DIM = 256
ROPE_THETA = 500000.0
EPS = 1e-6
NEG_INF = -1e30

MIX_WIDTH = D_MODEL
MLA_V_DIM = 64
MLA_NOPE_DIM = 64
MLA_ROPE_DIM = 32
MLA_QK_DIM = MLA_NOPE_DIM + MLA_ROPE_DIM
MLA_WIDTH = MIX_WIDTH // 2
MLA_HEADS = MLA_WIDTH // MLA_V_DIM
MLA_Q_RANK = 3 * D_MODEL // 8
MLA_KV_RANK = 4 * MLA_V_DIM
Q_BLOCK = 128
DIL_HEAD_DIM = 64
DIL_WIDTH = MIX_WIDTH - MLA_WIDTH
DIL_HEADS = DIL_WIDTH // DIL_HEAD_DIM
DIL_ROT_DIM = DIL_HEAD_DIM // 4
DIL_PATTERNS = ((128, 1), (512, 4), (2048, 16))
IN_SPLITS = (MLA_Q_RANK, MLA_KV_RANK, MLA_ROPE_DIM, DIL_WIDTH, DIL_WIDTH, DIL_WIDTH)
IN_WIDTH = sum(IN_SPLITS)
PEER_KEYS = 128
PEER_EXPERTS = PEER_KEYS * PEER_KEYS
PEER_HEADS = 8
PEER_QDIM = 128
PEER_HALF = PEER_QDIM // 2
PEER_TOPK = 16
PEER_CHUNK = 128

kernel_name = "hybrid_mla_dilswa_peer_encoder"


def rms_norm(x, g):
    xf = x.astype(jnp.float32)
    y = xf * lax.rsqrt(jnp.mean(xf * xf, axis=-1, keepdims=True) + EPS)
    return (y * g.astype(jnp.float32)).astype(x.dtype)


def rope_tables(seq, rot_dim):
    inv = ROPE_THETA ** (-jnp.arange(0, rot_dim, 2, dtype=jnp.float32) / rot_dim)
    ang = jnp.arange(seq, dtype=jnp.float32)[:, None] * inv[None, :]
    return jnp.cos(ang), jnp.sin(ang)


def apply_rope(x, cos, sin, rot_dim):
    half = rot_dim // 2
    shape = (x.shape[1],) + (1,) * (x.ndim - 3) + (half,)
    c = cos.reshape(shape).astype(x.dtype)
    s = sin.reshape(shape).astype(x.dtype)
    x1 = x[..., :half]
    x2 = x[..., half:rot_dim]
    return jnp.concatenate([x1 * c - x2 * s, x2 * c + x1 * s, x[..., rot_dim:]], axis=-1)


def mla_attention(q_nope, q_rope, k_nope, k_rope, v):
    B, S, H, _ = q_nope.shape
    nq = S // Q_BLOCK
    scale = MLA_QK_DIM ** -0.5

    def blocks(t):
        return jnp.moveaxis(t.reshape((B, nq, Q_BLOCK) + t.shape[2:]), 1, 0)

    def one_block(args):
        qn, qr = args
        s = jnp.einsum('bqhd,bkhd->bhqk', qn, k_nope) + jnp.einsum('bqhr,bkr->bhqk', qr, k_rope)
        w = jax.nn.softmax(s.astype(jnp.float32) * scale, axis=-1).astype(v.dtype)
        return jnp.einsum('bhqk,bkhd->bqhd', w, v)

    out = lax.map(one_block, (blocks(q_nope), blocks(q_rope)))
    return jnp.moveaxis(out, 0, 1).reshape(B, S, H, v.shape[-1])


def banded_attention(q, k, v, radius):
    N, L, hd = q.shape
    blk = radius
    nb = -(-L // blk)
    lp = nb * blk
    qb = jnp.pad(q, ((0, 0), (0, lp - L), (0, 0))).reshape(N, nb, blk, hd)

    def windows(t):
        tp = jnp.pad(t, ((0, 0), (blk, lp - L + blk), (0, 0))).reshape(N, nb + 2, blk, hd)
        return jnp.concatenate([tp[:, :-2], tp[:, 1:-1], tp[:, 2:]], axis=2)

    kw, vw = windows(k), windows(v)
    qpos = jnp.arange(nb)[:, None] * blk + jnp.arange(blk)[None, :]
    kpos = jnp.arange(nb)[:, None] * blk - blk + jnp.arange(3 * blk)[None, :]
    kp = kpos[:, None, :]
    mask = (jnp.abs(qpos[:, :, None] - kp) <= radius) & (kp >= 0) & (kp < L)
    s = jnp.einsum('nbqd,nbkd->nbqk', qb, kw).astype(jnp.float32) * (hd ** -0.5)
    s = jnp.where(mask, s, NEG_INF)
    m = jnp.max(s, axis=-1, keepdims=True)
    e = jnp.exp(s - m)
    den = jnp.sum(e, axis=-1, keepdims=True)
    out = jnp.einsum('nbqk,nbkd->nbqd', (e / den).astype(v.dtype), vw)
    lse = (m + jnp.log(den))[..., 0]
    return out.reshape(N, lp, hd)[:, :L], lse.reshape(N, lp)[:, :L]


def dilated_pattern(q, k, v, window, dil):
    B, S, H, hd = q.shape
    L = S // dil

    def to_sub(t):
        return t.reshape(B, L, dil, H, hd).transpose(0, 2, 3, 1, 4).reshape(B * dil * H, L, hd)

    o, l = banded_attention(to_sub(q), to_sub(k), to_sub(v), window // (2 * dil))
    o = o.reshape(B, dil, H, L, hd).transpose(0, 3, 1, 2, 4).reshape(B, S, H, hd)
    l = l.reshape(B, dil, H, L).transpose(0, 3, 1, 2).reshape(B, S, H)
    return o, l


def dilated_attention(q, k, v):
    outs, lses = [], []
    for window, dil in DIL_PATTERNS:
        o, l = dilated_pattern(q, k, v, window, dil)
        outs.append(o)
        lses.append(l)
    wts = jax.nn.softmax(jnp.stack(lses, axis=0), axis=0).astype(q.dtype)
    return jnp.einsum('pbsh,pbshd->bshd', wts, jnp.stack(outs, axis=0))


def peer_ffn(xn, w_q, keys1, keys2, u_tab, v_tab):
    B, S, D = xn.shape
    T = B * S
    xt = xn.reshape(T, D)
    q = (xt @ w_q).reshape(T, PEER_HEADS, 2, PEER_HALF)
    s1 = jnp.einsum('thd,kd->thk', q[:, :, 0], keys1)
    s2 = jnp.einsum('thd,kd->thk', q[:, :, 1], keys2)
    v1, i1 = lax.top_k(s1, PEER_TOPK)
    v2, i2 = lax.top_k(s2, PEER_TOPK)
    cand = (v1[..., :, None] + v2[..., None, :]).reshape(T, PEER_HEADS, PEER_TOPK * PEER_TOPK)
    cidx = (i1[..., :, None] * PEER_KEYS + i2[..., None, :]).reshape(T, PEER_HEADS, PEER_TOPK * PEER_TOPK)
    top, pos = lax.top_k(cand, PEER_TOPK)
    eidx = jnp.take_along_axis(cidx, pos, axis=-1)
    g = jax.nn.softmax(top.astype(jnp.float32), axis=-1).astype(xn.dtype)
    nc = T // PEER_CHUNK

    def chunk(args):
        xc, ec, gc = args
        a = jax.nn.gelu(jnp.einsum('td,thkd->thk', xc, u_tab[ec]), approximate=False)
        return jnp.einsum('thk,thkd->td', gc * a, v_tab[ec])

    y = lax.map(chunk, (xt.reshape(nc, PEER_CHUNK, D),
                        eidx.reshape(nc, PEER_CHUNK, PEER_HEADS, PEER_TOPK),
                        g.reshape(nc, PEER_CHUNK, PEER_HEADS, PEER_TOPK)))
    return y.reshape(B, S, D)


def setup_inputs(seed: int = 0) -> dict:
    key = jax.random.key(seed)
    ks = jax.random.split(key, 24)
    f32 = jnp.float32

    def nrm(k, shape, scale):
        return jax.random.normal(k, shape, f32) * scale

    def gain(k, shape):
        return 1.0 + 0.01 * jax.random.normal(k, shape, f32)

    L = DEPTH
    return {
        "x": nrm(ks[0], (BATCH, SEQ, D_MODEL), 1.0),
        "p": nrm(ks[1], (DEPTH, BATCH, SEQ, PLE_DIM), 1.0),
        "g_mix": gain(ks[2], (L, D_MODEL)),
        "w_in": nrm(ks[3], (L, D_MODEL, IN_WIDTH), D_MODEL ** -0.5),
        "g_cq": gain(ks[4], (L, MLA_Q_RANK)),
        "w_uq": nrm(ks[5], (L, MLA_Q_RANK, MLA_HEADS * MLA_QK_DIM), MLA_Q_RANK ** -0.5),
        "g_ckv": gain(ks[6], (L, MLA_KV_RANK)),
        "w_ukv": nrm(ks[7], (L, MLA_KV_RANK, MLA_HEADS * (MLA_NOPE_DIM + MLA_V_DIM)), MLA_KV_RANK ** -0.5),
        "g_out_mla": gain(ks[8], (L, MLA_WIDTH)),
        "g_out_dil": gain(ks[9], (L, DIL_WIDTH)),
        "w_out": nrm(ks[10], (L, MIX_WIDTH, D_MODEL), MIX_WIDTH ** -0.5),
        "g_ffn": gain(ks[11], (L, D_MODEL)),
        "w_peer_q": nrm(ks[12], (L, D_MODEL, PEER_HEADS * PEER_QDIM), D_MODEL ** -0.5),
        "peer_keys1": nrm(ks[13], (L, PEER_KEYS, PEER_HALF), PEER_HALF ** -0.5),
        "peer_keys2": nrm(ks[14], (L, PEER_KEYS, PEER_HALF), PEER_HALF ** -0.5),
        "peer_u": nrm(ks[15], (L, PEER_EXPERTS, D_MODEL), D_MODEL ** -0.5),
        "peer_v": nrm(ks[16], (L, PEER_EXPERTS, D_MODEL), 0.5),
        "g_ple": gain(ks[17], (L, D_MODEL)),
        "w_ple_gate": nrm(ks[18], (L, D_MODEL, D_MODEL), D_MODEL ** -0.5),
        "w_ple_proj": nrm(ks[19], (L, PLE_DIM, D_MODEL), PLE_DIM ** -0.5),
        "g_final": gain(ks[20], (D_MODEL,)),
    }


def reference(x, p, g_mix, w_in, g_cq, w_uq, g_ckv, w_ukv, g_out_mla, g_out_dil, w_out,
              g_ffn, w_peer_q, peer_keys1, peer_keys2, peer_u, peer_v,
              g_ple, w_ple_gate, w_ple_proj, g_final):
    B, S, _ = x.shape
    cos_m, sin_m = rope_tables(S, MLA_ROPE_DIM)
    cos_d, sin_d = rope_tables(S, DIL_ROT_DIM)
    offs = np.cumsum(IN_SPLITS)[:-1].tolist()
    h = x
    for i in range(DEPTH):
        hn = rms_norm(h, g_mix[i])
        c_q, c_kv, k_r, q_d, k_d, v_d = jnp.split(hn @ w_in[i], offs, axis=-1)
        q = (rms_norm(c_q, g_cq[i]) @ w_uq[i]).reshape(B, S, MLA_HEADS, MLA_QK_DIM)
        q_nope = q[..., :MLA_NOPE_DIM]
        q_rope = apply_rope(q[..., MLA_NOPE_DIM:], cos_m, sin_m, MLA_ROPE_DIM)
        kv = (rms_norm(c_kv, g_ckv[i]) @ w_ukv[i]).reshape(B, S, MLA_HEADS, MLA_NOPE_DIM + MLA_V_DIM)
        k_nope = kv[..., :MLA_NOPE_DIM]
        v_m = kv[..., MLA_NOPE_DIM:]
        k_rope = apply_rope(k_r, cos_m, sin_m, MLA_ROPE_DIM)
        o_mla = mla_attention(q_nope, q_rope, k_nope, k_rope, v_m).reshape(B, S, MLA_WIDTH)
        qd = apply_rope(q_d.reshape(B, S, DIL_HEADS, DIL_HEAD_DIM), cos_d, sin_d, DIL_ROT_DIM)
        kd = apply_rope(k_d.reshape(B, S, DIL_HEADS, DIL_HEAD_DIM), cos_d, sin_d, DIL_ROT_DIM)
        vd = v_d.reshape(B, S, DIL_HEADS, DIL_HEAD_DIM)
        o_dil = dilated_attention(qd, kd, vd).reshape(B, S, DIL_WIDTH)
        mixed = jnp.concatenate([rms_norm(o_mla, g_out_mla[i]), rms_norm(o_dil, g_out_dil[i])], axis=-1)
        h = h + mixed @ w_out[i]
        h = h + peer_ffn(rms_norm(h, g_ffn[i]), w_peer_q[i], peer_keys1[i], peer_keys2[i],
                         peer_u[i], peer_v[i])
        gate = jax.nn.sigmoid(rms_norm(h, g_ple[i]) @ w_ple_gate[i])
        h = h + gate * (p[i] @ w_ple_proj[i])
    return rms_norm(h, g_final)
```

```cpp
#include <hip/hip_runtime.h>
#include <stdint.h>
#include <cstdio>

typedef unsigned short bf16_t;
typedef short bf16x8 __attribute__((ext_vector_type(8)));
typedef float f32x4 __attribute__((ext_vector_type(4)));
typedef unsigned u32x4 __attribute__((ext_vector_type(4)));
typedef unsigned u32x2 __attribute__((ext_vector_type(2)));

constexpr int T_ = 16384, S_ = 2048, NB_ = 8, D_ = 1024;
constexpr int NIN = 2304;
constexpr int C_QD = 0, C_KD = 512, C_VD = 1024, C_CQ = 1536, C_CKV = 1920, C_KR = 2176, C_END = 2208;
constexpr float EPS_ = 1e-6f;
constexpr float LOG2E = 1.4426950408889634f;
constexpr float QS_MLA = 0.10206207261596577f * LOG2E;
constexpr float QS_DIL = 0.125f * LOG2E;

constexpr size_t MiB = 1ull << 20;
constexpr size_t O_BAR   = 0;
constexpr size_t O_WIN   = 1 * MiB;
constexpr size_t O_WUQ   = 6 * MiB;
constexpr size_t O_WUKV  = 7 * MiB;
constexpr size_t O_WOUT  = 8 * MiB;
constexpr size_t O_WPQ   = 10 * MiB;
constexpr size_t O_WPG   = 12 * MiB;
constexpr size_t O_WPP   = 14 * MiB;
constexpr size_t O_K1B   = 14 * MiB + 512 * 1024;
constexpr size_t O_K2B   = O_K1B + 16384;
constexpr size_t O_COSM  = 15 * MiB;
constexpr size_t O_SINM  = O_COSM + 131072;
constexpr size_t O_COSD  = O_SINM + 131072;
constexpr size_t O_SIND  = O_COSD + 65536;
constexpr size_t O_RSTDX = O_SIND + 65536;
constexpr size_t O_SSQQ  = 16 * MiB;
constexpr size_t O_SSQKV = O_SSQQ + (size_t)T_ * 6 * 4;
constexpr size_t O_SSMLA = 17 * MiB;
constexpr size_t O_LSE   = 18 * MiB;
constexpr size_t O_SSQH  = 20 * MiB;
constexpr size_t O_RSTD2 = 21 * MiB;
constexpr size_t O_SSQ3  = 21 * MiB + 512 * 1024;
constexpr size_t O_PB    = 23 * MiB;
constexpr size_t O_D     = 31 * MiB;
constexpr size_t O_XB    = O_D;
constexpr size_t O_MIXED = O_D;
constexpr size_t O_CQ    = O_D + 32 * MiB;
constexpr size_t O_CKV   = O_D + 44 * MiB;
constexpr size_t O_QD    = O_D + 52 * MiB;
constexpr size_t O_KD    = O_D + 68 * MiB;
constexpr size_t O_VTD   = O_D + 84 * MiB;
constexpr size_t O_QM    = O_D + 132 * MiB;
constexpr size_t O_KM    = O_D + 156 * MiB;
constexpr size_t O_VTM   = O_D + 180 * MiB;
constexpr size_t O_H     = O_D + 52 * MiB;
constexpr size_t O_HG    = O_D + 116 * MiB;
constexpr size_t O_UB    = O_D + 148 * MiB;
constexpr size_t O_VB    = O_D + 180 * MiB;
constexpr size_t O_EIDX  = O_D + 212 * MiB;
constexpr size_t O_GATE  = O_D + 216 * MiB;
constexpr size_t WS_NEED = 256 * MiB;
constexpr size_t O_NV1   = O_D + 16 * MiB;
constexpr size_t O_NI1   = O_D + 24 * MiB;
constexpr size_t O_NV2   = O_D + 32 * MiB;
constexpr size_t O_NI2   = O_D + 40 * MiB;

struct Params {
    const float *x, *p, *g_mix, *w_in, *g_cq, *w_uq, *g_ckv, *w_ukv, *g_out_mla, *g_out_dil, *w_out, *g_ffn, *w_peer_q,
        *keys1, *keys2, *peer_u, *peer_v, *g_ple, *w_ple_gate, *w_ple_proj, *g_final;
    float* out;
    unsigned char* ws;
};

__device__ __forceinline__ bf16_t f2bf(float f) { unsigned u = __float_as_uint(f); u += 0x7fffu + ((u >> 16) & 1u); return (bf16_t)(u >> 16); }
__device__ __forceinline__ float bf2f(bf16_t b) { return __uint_as_float(((unsigned)b) << 16); }
__device__ __forceinline__ unsigned pack2(float a, float b) { return (unsigned)f2bf(a) | ((unsigned)f2bf(b) << 16); }
__device__ __forceinline__ float bflo(unsigned w) { return __uint_as_float(w << 16); }
__device__ __forceinline__ float bfhi(unsigned w) { return __uint_as_float(w & 0xffff0000u); }
__device__ __forceinline__ float wave_sum(float v) {
#pragma unroll
    for (int o = 32; o >= 1; o >>= 1) v += __shfl_xor(v, o);
    return v;
}
template <typename Tp> __host__ __device__ __forceinline__ Tp* wsp(const Params& P, size_t off) { return (Tp*)(P.ws + off); }

__device__ __forceinline__ int dil_of(int p) { return p == 0 ? 1 : (p == 1 ? 4 : 16); }
__device__ __forceinline__ int respos(int s, int dil) { return (s % dil) * (S_ / dil) + s / dil; }

__device__ __forceinline__ int win_src_col(int n) {
    if (n < 512) return 672 + n;
    if (n < 1024) return 1184 + (n - 512);
    if (n < 1536) return 1696 + (n - 1024);
    if (n < 1920) return n - 1536;
    if (n < 2176) return 384 + (n - 1920);
    if (n < 2208) return 640 + (n - 2176);
    return -1;
}
__device__ __forceinline__ void wt_job(const float* __restrict__ W, int Nsrc, int K, int srccol, const float* __restrict__ g0, const float* __restrict__ g1, int gsplit,
                                       bf16_t* __restrict__ Wt, int n, int k0) {
    unsigned w[4];
#pragma unroll
    for (int j = 0; j < 4; ++j) {
        float a = 0.f, b = 0.f;
        if (srccol >= 0) {
            const int ka = k0 + 2 * j, kb = ka + 1;
            a = W[(size_t)ka * Nsrc + srccol]; b = W[(size_t)kb * Nsrc + srccol];
            if (g0) { a *= (ka < gsplit ? g0[ka] : g1[ka - gsplit]); b *= (kb < gsplit ? g0[kb] : g1[kb - gsplit]); }
        }
        w[j] = pack2(a, b);
    }
    *(u32x4*)(Wt + (size_t)n * K + k0) = (u32x4){w[0], w[1], w[2], w[3]};
}

__device__ void prep_weights(const Params& P, long gtid, long gthreads) {
    for (long i = gtid; i < (long)NIN * 128; i += gthreads) { const int n = (int)(i % NIN), kc = (int)(i / NIN);
        wt_job(P.w_in, 2208, 1024, win_src_col(n), P.g_mix, P.g_mix, 1 << 30, wsp<bf16_t>(P, O_WIN), n, kc * 8); }
    for (long i = gtid; i < 768L * 48; i += gthreads) { const int n = (int)(i % 768), kc = (int)(i / 768);
        wt_job(P.w_uq, 768, 384, n, P.g_cq, P.g_cq, 1 << 30, wsp<bf16_t>(P, O_WUQ), n, kc * 8); }
    for (long i = gtid; i < 1024L * 32; i += gthreads) { const int n = (int)(i % 1024), kc = (int)(i / 1024);
        wt_job(P.w_ukv, 1024, 256, n, P.g_ckv, P.g_ckv, 1 << 30, wsp<bf16_t>(P, O_WUKV), n, kc * 8); }
    for (long i = gtid; i < 1024L * 128; i += gthreads) { const int n = (int)(i % 1024), kc = (int)(i / 1024);
        wt_job(P.w_out, 1024, 1024, n, P.g_out_mla, P.g_out_dil, 512, wsp<bf16_t>(P, O_WOUT), n, kc * 8);
        wt_job(P.w_peer_q, 1024, 1024, n, nullptr, nullptr, 0, wsp<bf16_t>(P, O_WPQ), n, kc * 8);
        wt_job(P.w_ple_gate, 1024, 1024, n, nullptr, nullptr, 0, wsp<bf16_t>(P, O_WPG), n, kc * 8); }
    for (long i = gtid; i < 1024L * 32; i += gthreads) { const int n = (int)(i % 1024), kc = (int)(i / 1024);
        wt_job(P.w_ple_proj, 1024, 256, n, nullptr, nullptr, 0, wsp<bf16_t>(P, O_WPP), n, kc * 8); }
    for (long i = gtid; i < 128L * 64; i += gthreads) { wsp<bf16_t>(P, O_K1B)[i] = f2bf(P.keys1[i]); wsp<bf16_t>(P, O_K2B)[i] = f2bf(P.keys2[i]); }
    for (long i = gtid; i < 2048L * 16; i += gthreads) { const int s = (int)(i >> 4), j = (int)(i & 15);
        const float inv = powf(500000.0f, -(float)(2 * j) / 32.0f); const float ang = (float)s * inv; float sn, cs; sincosf(ang, &sn, &cs);
        wsp<float>(P, O_COSM)[i] = cs; wsp<float>(P, O_SINM)[i] = sn; }
    for (long i = gtid; i < 2048L * 8; i += gthreads) { const int s = (int)(i >> 3), j = (int)(i & 7);
        const float inv = powf(500000.0f, -(float)(2 * j) / 16.0f); const float ang = (float)s * inv; float sn, cs; sincosf(ang, &sn, &cs);
        wsp<float>(P, O_COSD)[i] = cs; wsp<float>(P, O_SIND)[i] = sn; }
}
__device__ void prep_rows(const Params& P, long gwave, long gwaves, int lane) {
    for (long t = gwave; t < T_; t += gwaves) {
        const float* xr = P.x + (size_t)t * D_;
        float ss = 0.f; f32x4 v[4];
#pragma unroll
        for (int i = 0; i < 4; ++i) { v[i] = *(const f32x4*)(xr + i * 256 + lane * 4); ss += v[i][0] * v[i][0] + v[i][1] * v[i][1] + v[i][2] * v[i][2] + v[i][3] * v[i][3]; }
        ss = wave_sum(ss);
        bf16_t* xb = wsp<bf16_t>(P, O_XB) + (size_t)t * D_;
#pragma unroll
        for (int i = 0; i < 4; ++i) *(u32x2*)(xb + i * 256 + lane * 4) = (u32x2){pack2(v[i][0], v[i][1]), pack2(v[i][2], v[i][3])};
        if (lane == 0) wsp<float>(P, O_RSTDX)[t] = rsqrtf(ss * (1.0f / D_) + EPS_);
        const f32x4 pv = *(const f32x4*)(P.p + (size_t)t * 256 + lane * 4);
        *(u32x2*)(wsp<bf16_t>(P, O_PB) + (size_t)t * 256 + lane * 4) = (u32x2){pack2(pv[0], pv[1]), pack2(pv[2], pv[3])};
    }
}
__device__ void prep_tables(const Params& P, long gtid, long gthreads) {
    const long n8 = 16384L * 1024 / 8;
    for (long i = gtid; i < n8; i += gthreads) {
        const f32x4 a = *(const f32x4*)(P.peer_u + i * 8), b = *(const f32x4*)(P.peer_u + i * 8 + 4);
        *(u32x4*)(wsp<bf16_t>(P, O_UB) + i * 8) = (u32x4){pack2(a[0], a[1]), pack2(a[2], a[3]), pack2(b[0], b[1]), pack2(b[2], b[3])};
        const f32x4 c = *(const f32x4*)(P.peer_v + i * 8), d = *(const f32x4*)(P.peer_v + i * 8 + 4);
        *(u32x4*)(wsp<bf16_t>(P, O_VB) + i * 8) = (u32x4){pack2(c[0], c[1]), pack2(c[2], c[3]), pack2(d[0], d[1]), pack2(d[2], d[3])};
    }
}

__global__ void __launch_bounds__(256) k_prep(Params P) {
    const long gtid = (long)blockIdx.x * 256 + threadIdx.x, gthreads = (long)gridDim.x * 256;
    prep_weights(P, gtid, gthreads);
    prep_rows(P, gtid >> 6, gthreads >> 6, threadIdx.x & 63);
}
__global__ void __launch_bounds__(256) k_prep_tables(Params P) {
    prep_tables(P, (long)blockIdx.x * 256 + threadIdx.x, (long)gridDim.x * 256);
}

__device__ __forceinline__ float ndot(const bf16_t* __restrict__ a, const bf16_t* __restrict__ b, int K) {
    float acc = 0.f;
    for (int k = 0; k < K; k += 8) {
        const u32x4 x = *(const u32x4*)(a + k), y = *(const u32x4*)(b + k);
#pragma unroll
        for (int j = 0; j < 4; ++j) acc += bflo(x[j]) * bflo(y[j]) + bfhi(x[j]) * bfhi(y[j]);
    }
    return acc;
}
__global__ void __launch_bounds__(256) n_gemm1(Params P) {
    const long idx = (long)blockIdx.x * 256 + threadIdx.x; if (idx >= (long)T_ * C_END) return;
    const int n = (int)(idx % C_END), t = (int)(idx / C_END), b = t / S_, s = t % S_;
    const bf16_t* xb = wsp<bf16_t>(P, O_XB) + (size_t)t * D_; const bf16_t* W = wsp<bf16_t>(P, O_WIN);
    const float rs = wsp<float>(P, O_RSTDX)[t];
    float v = rs * ndot(xb, W + (size_t)n * D_, D_);
    if (n < C_VD) {
        const bool isq = n < C_KD; const int c = isq ? n : n - C_KD, h = c >> 6, d = c & 63;
        if (d < 16) { const int pn = d < 8 ? n + 8 : n - 8; const float pv = rs * ndot(xb, W + (size_t)pn * D_, D_);
            const float cs = wsp<float>(P, O_COSD)[s * 8 + (d & 7)], sn = wsp<float>(P, O_SIND)[s * 8 + (d & 7)];
            v = d < 8 ? v * cs - pv * sn : v * cs + pv * sn; }
        if (isq) v *= QS_DIL;
        wsp<bf16_t>(P, isq ? O_QD : O_KD)[(((size_t)b * 8 + h) * S_ + s) * 64 + d] = f2bf(v);
    } else if (n < C_CQ) {
        const int c = n - C_VD, h = c >> 6, d = c & 63;
        for (int p = 0; p < 3; ++p) wsp<bf16_t>(P, O_VTD)[(size_t)p * T_ * 512 + (((size_t)b * 8 + h) * 64 + d) * S_ + respos(s, dil_of(p))] = f2bf(v);
    } else if (n < C_CKV) { wsp<bf16_t>(P, O_CQ)[(size_t)t * 384 + (n - C_CQ)] = f2bf(v);
    } else if (n < C_KR) { wsp<bf16_t>(P, O_CKV)[(size_t)t * 256 + (n - C_CKV)] = f2bf(v);
    } else {
        const int j = n - C_KR; const int pn = j < 16 ? n + 16 : n - 16; const float pv = rs * ndot(xb, W + (size_t)pn * D_, D_);
        const float cs = wsp<float>(P, O_COSM)[s * 16 + (j & 15)], sn = wsp<float>(P, O_SINM)[s * 16 + (j & 15)];
        v = j < 16 ? v * cs - pv * sn : v * cs + pv * sn;
        for (int h = 0; h < 8; ++h) wsp<bf16_t>(P, O_KM)[(((size_t)b * 8 + h) * S_ + s) * 96 + 64 + j] = f2bf(v);
    }
}
__global__ void __launch_bounds__(256) n_ssq_bf16(Params P, int sel) {
    const bf16_t* buf = sel == 0 ? wsp<bf16_t>(P, O_CQ) : (sel == 1 ? wsp<bf16_t>(P, O_CKV) : (const bf16_t*)P.out);
    float* out = wsp<float>(P, sel == 0 ? O_SSQQ : (sel == 1 ? O_SSQKV : O_SSMLA));
    const int ld = sel == 0 ? 384 : (sel == 1 ? 256 : 512), ngran = ld / 64;
    const long idx = (long)blockIdx.x * 256 + threadIdx.x; if (idx >= (long)T_ * ngran) return;
    const int g = (int)(idx % ngran), t = (int)(idx / ngran); float s = 0.f;
    for (int j = 0; j < 64; ++j) { const float v = bf2f(buf[(size_t)t * ld + g * 64 + j]); s += v * v; }
    out[idx] = s;
}
__global__ void __launch_bounds__(256) n_ssq_f32(Params P, int sel) {
    const float* buf = sel == 0 ? wsp<float>(P, O_H) : P.out; float* out = wsp<float>(P, sel == 0 ? O_SSQH : O_SSQ3);
    const int ld = 1024, ngran = 16;
    const long idx = (long)blockIdx.x * 256 + threadIdx.x; if (idx >= (long)T_ * ngran) return;
    const int g = (int)(idx % ngran), t = (int)(idx / ngran); float s = 0.f;
    for (int j = 0; j < 64; ++j) { const float v = buf[(size_t)t * ld + g * 64 + j]; s += v * v; }
    out[idx] = s;
}
__device__ __forceinline__ float rstd_from(const float* part, int n, float invdim) { float s = 0.f; for (int i = 0; i < n; ++i) s += part[i]; return rsqrtf(s * invdim + EPS_); }
__global__ void __launch_bounds__(256) n_qup(Params P) {
    const long idx = (long)blockIdx.x * 256 + threadIdx.x; if (idx >= (long)T_ * 768) return;
    const int n = (int)(idx % 768), t = (int)(idx / 768), b = t / S_, s = t % S_;
    const bf16_t* a = wsp<bf16_t>(P, O_CQ) + (size_t)t * 384; const bf16_t* W = wsp<bf16_t>(P, O_WUQ);
    const float rs = rstd_from(wsp<float>(P, O_SSQQ) + (size_t)t * 6, 6, 1.0f / 384.0f);
    float v = rs * ndot(a, W + (size_t)n * 384, 384);
    const int h = n / 96, d = n % 96;
    if (d >= 64) { const int j = d - 64; const int pn = j < 16 ? n + 16 : n - 16; const float pv = rs * ndot(a, W + (size_t)pn * 384, 384);
        const float cs = wsp<float>(P, O_COSM)[s * 16 + (j & 15)], sn = wsp<float>(P, O_SINM)[s * 16 + (j & 15)];
        v = j < 16 ? v * cs - pv * sn : v * cs + pv * sn; }
    wsp<bf16_t>(P, O_QM)[(((size_t)b * 8 + h) * S_ + s) * 96 + d] = f2bf(v * QS_MLA);
}
__global__ void __launch_bounds__(256) n_kvup(Params P) {
    const long idx = (long)blockIdx.x * 256 + threadIdx.x; if (idx >= (long)T_ * 1024) return;
    const int n = (int)(idx % 1024), t = (int)(idx / 1024), b = t / S_, s = t % S_;
    const bf16_t* a = wsp<bf16_t>(P, O_CKV) + (size_t)t * 256; const bf16_t* W = wsp<bf16_t>(P, O_WUKV);
    const float rs = rstd_from(wsp<float>(P, O_SSQKV) + (size_t)t * 4, 4, 1.0f / 256.0f);
    const float v = rs * ndot(a, W + (size_t)n * 256, 256);
    const int h = n >> 7, d = n & 127;
    if (d < 64) wsp<bf16_t>(P, O_KM)[(((size_t)b * 8 + h) * S_ + s) * 96 + d] = f2bf(v);
    else wsp<bf16_t>(P, O_VTM)[(((size_t)b * 8 + h) * 64 + (d - 64)) * S_ + s] = f2bf(v);
}
__global__ void __launch_bounds__(256) n_mla(Params P) {
    bf16_t* omla = (bf16_t*)P.out;
    const long idx = (long)blockIdx.x * 256 + threadIdx.x; if (idx >= (long)T_ * 8 * 4) return;
    const int dq = (int)(idx & 3); const long r = idx >> 2; const int s = (int)(r % S_); const int bh = (int)(r / S_);
    const bf16_t* q = wsp<bf16_t>(P, O_QM) + ((size_t)bh * S_ + s) * 96; const bf16_t* K = wsp<bf16_t>(P, O_KM) + (size_t)bh * S_ * 96;
    const bf16_t* Vt = wsp<bf16_t>(P, O_VTM) + (size_t)bh * 64 * S_;
    float m = -1e30f;
    for (int k = 0; k < S_; ++k) m = fmaxf(m, ndot(q, K + (size_t)k * 96, 96));
    float l = 0.f, o[16];
#pragma unroll
    for (int i = 0; i < 16; ++i) o[i] = 0.f;
    for (int k = 0; k < S_; ++k) { const float pw = exp2f(ndot(q, K + (size_t)k * 96, 96) - m); l += pw;
#pragma unroll
        for (int i = 0; i < 16; ++i) o[i] += pw * bf2f(Vt[(size_t)(dq * 16 + i) * S_ + k]); }
    const int b = bh >> 3, h = bh & 7; const float il = 1.0f / l;
#pragma unroll
    for (int i = 0; i < 16; ++i) omla[((size_t)b * S_ + s) * 512 + h * 64 + dq * 16 + i] = f2bf(o[i] * il);
}
__global__ void __launch_bounds__(256) n_dil(Params P) {
    bf16_t* opart = (bf16_t*)P.out + (size_t)T_ * 512;
    const long idx = (long)blockIdx.x * 256 + threadIdx.x; if (idx >= 3L * T_ * 8 * 4) return;
    const int dq = (int)(idx & 3); long r = idx >> 2; const int s = (int)(r % S_); r /= S_; const int bh = (int)(r % 64); const int p = (int)(r / 64);
    const int dil = dil_of(p);
    const bf16_t* q = wsp<bf16_t>(P, O_QD) + ((size_t)bh * S_ + s) * 64; const bf16_t* K = wsp<bf16_t>(P, O_KD) + (size_t)bh * S_ * 64;
    const bf16_t* Vt = wsp<bf16_t>(P, O_VTD) + (size_t)p * T_ * 512 + (size_t)bh * 64 * S_;
    float m = -1e30f;
    for (int i = -64; i <= 64; ++i) { const int kp = s + i * dil; if (kp < 0 || kp >= S_) continue; m = fmaxf(m, ndot(q, K + (size_t)kp * 64, 64)); }
    float l = 0.f, o[16];
#pragma unroll
    for (int i = 0; i < 16; ++i) o[i] = 0.f;
    for (int i = -64; i <= 64; ++i) { const int kp = s + i * dil; if (kp < 0 || kp >= S_) continue;
        const float pw = exp2f(ndot(q, K + (size_t)kp * 64, 64) - m); l += pw; const int rp = respos(kp, dil);
#pragma unroll
        for (int j = 0; j < 16; ++j) o[j] += pw * bf2f(Vt[(size_t)(dq * 16 + j) * S_ + rp]); }
    const int b = bh >> 3, h = bh & 7; const size_t t = (size_t)b * S_ + s; const float il = 1.0f / l;
#pragma unroll
    for (int j = 0; j < 16; ++j) opart[(size_t)p * T_ * 512 + t * 512 + h * 64 + dq * 16 + j] = f2bf(o[j] * il);
    if (dq == 0) wsp<float>(P, O_LSE)[((size_t)p * T_ + t) * 8 + h] = m + log2f(l);
}
__device__ void merge_rows(const Params& P, const bf16_t* omla, const bf16_t* opart, long gwave, long gwaves, int lane) {
    for (long t = gwave; t < T_; t += gwaves) {
        const int h = lane >> 3;
        const float* lse = wsp<float>(P, O_LSE);
        const float l0 = lse[((size_t)0 * T_ + t) * 8 + h], l1 = lse[((size_t)1 * T_ + t) * 8 + h], l2 = lse[((size_t)2 * T_ + t) * 8 + h];
        const float mx = fmaxf(l0, fmaxf(l1, l2)); float w0 = exp2f(l0 - mx), w1 = exp2f(l1 - mx), w2 = exp2f(l2 - mx); const float iw = 1.0f / (w0 + w1 + w2); w0 *= iw; w1 *= iw; w2 *= iw;
        const u32x4 a0 = *(const u32x4*)(opart + (size_t)0 * T_ * 512 + (size_t)t * 512 + lane * 8), a1 = *(const u32x4*)(opart + (size_t)1 * T_ * 512 + (size_t)t * 512 + lane * 8),
                    a2 = *(const u32x4*)(opart + (size_t)2 * T_ * 512 + (size_t)t * 512 + lane * 8);
        float od[8]; float ssd = 0.f;
#pragma unroll
        for (int j = 0; j < 4; ++j) { od[2 * j] = w0 * bflo(a0[j]) + w1 * bflo(a1[j]) + w2 * bflo(a2[j]); od[2 * j + 1] = w0 * bfhi(a0[j]) + w1 * bfhi(a1[j]) + w2 * bfhi(a2[j]);
            ssd += od[2 * j] * od[2 * j] + od[2 * j + 1] * od[2 * j + 1]; }
        ssd = wave_sum(ssd); const float rd = rsqrtf(ssd * (1.0f / 512.0f) + EPS_);
        const float rm = rstd_from(wsp<float>(P, O_SSMLA) + (size_t)t * 8, 8, 1.0f / 512.0f);
        const u32x4 am = *(const u32x4*)(omla + (size_t)t * 512 + lane * 8);
        bf16_t* mx_ = wsp<bf16_t>(P, O_MIXED) + (size_t)t * D_;
        *(u32x4*)(mx_ + lane * 8) = (u32x4){pack2(bflo(am[0]) * rm, bfhi(am[0]) * rm), pack2(bflo(am[1]) * rm, bfhi(am[1]) * rm), pack2(bflo(am[2]) * rm, bfhi(am[2]) * rm), pack2(bflo(am[3]) * rm, bfhi(am[3]) * rm)};
        *(u32x4*)(mx_ + 512 + lane * 8) = (u32x4){pack2(od[0] * rd, od[1] * rd), pack2(od[2] * rd, od[3] * rd), pack2(od[4] * rd, od[5] * rd), pack2(od[6] * rd, od[7] * rd)};
    }
}
__global__ void __launch_bounds__(256) k_merge(Params P) {
    merge_rows(P, (const bf16_t*)P.out, (const bf16_t*)P.out + (size_t)T_ * 512, ((long)blockIdx.x * 256 + threadIdx.x) >> 6, ((long)gridDim.x * 256) >> 6, threadIdx.x & 63);
}
__global__ void __launch_bounds__(256) n_outproj(Params P) {
    const long idx = (long)blockIdx.x * 256 + threadIdx.x; if (idx >= (long)T_ * 1024) return;
    const int n = (int)(idx & 1023), t = (int)(idx >> 10);
    const float v = ndot(wsp<bf16_t>(P, O_MIXED) + (size_t)t * D_, wsp<bf16_t>(P, O_WOUT) + (size_t)n * D_, D_) + P.x[idx];
    wsp<float>(P, O_H)[idx] = v; wsp<bf16_t>(P, O_HG)[idx] = f2bf(v * P.g_ffn[n]);
}
__global__ void __launch_bounds__(256) n_peerq(Params P) {
    float* qf = P.out;
    const long idx = (long)blockIdx.x * 256 + threadIdx.x; if (idx >= (long)T_ * 1024) return;
    const int n = (int)(idx & 1023), t = (int)(idx >> 10);
    const float rs = rstd_from(wsp<float>(P, O_SSQH) + (size_t)t * 16, 16, 1.0f / 1024.0f);
    qf[idx] = rs * ndot(wsp<bf16_t>(P, O_HG) + (size_t)t * D_, wsp<bf16_t>(P, O_WPQ) + (size_t)n * D_, D_);
}
__global__ void __launch_bounds__(256) n_topk1(Params P) {
    const long idx = (long)blockIdx.x * 256 + threadIdx.x; if (idx >= (long)T_ * 16) return;
    const int half = (int)(idx & 1); const long th = idx >> 1;
    const int t_ = (int)(th >> 3), h_ = (int)(th & 7);
    const float* q = P.out + (size_t)t_ * 1024 + h_ * 128 + half * 64; const float* keys = half ? P.keys2 : P.keys1;
    float* vo = wsp<float>(P, half ? O_NV2 : O_NV1) + th * 16; int* io = wsp<int>(P, half ? O_NI2 : O_NI1) + th * 16;
    float pv = 3e38f; int pi = -1;
    for (int r = 0; r < 16; ++r) { float bv = -3e38f; int bi = 0;
        for (int k = 0; k < 128; ++k) { float v = 0.f; for (int d = 0; d < 64; ++d) v += q[d] * keys[k * 64 + d]; const bool elig = (v < pv) || (v == pv && k > pi); if (elig && (v > bv)) { bv = v; bi = k; } }
        vo[r] = bv; io[r] = bi; pv = bv; pi = bi; }
}
__global__ void __launch_bounds__(256) n_topk2(Params P) {
    const long th = (long)blockIdx.x * 256 + threadIdx.x; if (th >= (long)T_ * 8) return;
    const float* v1 = wsp<float>(P, O_NV1) + th * 16; const float* v2 = wsp<float>(P, O_NV2) + th * 16;
    const int* i1 = wsp<int>(P, O_NI1) + th * 16; const int* i2 = wsp<int>(P, O_NI2) + th * 16;
    unsigned short* eo = wsp<unsigned short>(P, O_EIDX) + th * 16; float* go = wsp<float>(P, O_GATE) + th * 16;
    float pv = 3e38f; int pi = -1; float top0 = 0.f, den = 0.f;
    for (int r = 0; r < 16; ++r) { float bv = -3e38f; int bi = 0;
        for (int c = 0; c < 256; ++c) { const float v = v1[c >> 4] + v2[c & 15]; const bool elig = (v < pv) || (v == pv && c > pi); if (elig && (v > bv)) { bv = v; bi = c; } }
        if (r == 0) top0 = bv; const float e = __expf(bv - top0); den += e; go[r] = e; eo[r] = (unsigned short)(i1[bi >> 4] * 128 + i2[bi & 15]); pv = bv; pi = bi; }
    const float id = 1.0f / den;
    for (int r = 0; r < 16; ++r) go[r] *= id;
}
__global__ void __launch_bounds__(256) n_peer_a(Params P) {
    const long idx = (long)blockIdx.x * 256 + threadIdx.x; if (idx >= (long)T_ * 128) return;
    const int t = (int)(idx >> 7);
    const float rs = rstd_from(wsp<float>(P, O_SSQH) + (size_t)t * 16, 16, 1.0f / 1024.0f);
    const int e = wsp<unsigned short>(P, O_EIDX)[idx];
    const float a = rs * ndot(wsp<bf16_t>(P, O_HG) + (size_t)t * D_, wsp<bf16_t>(P, O_UB) + (size_t)e * D_, D_);
    const float ge = 0.5f * a * (1.0f + erff(a * 0.70710678118654752f));
    wsp<float>(P, O_GATE)[idx] *= ge;
}
__global__ void __launch_bounds__(256) n_peer_b(Params P) {
    const long idx = (long)blockIdx.x * 256 + threadIdx.x; if (idx >= (long)T_ * 1024) return;
    const int n = (int)(idx & 1023), t = (int)(idx >> 10);
    const unsigned short* ei = wsp<unsigned short>(P, O_EIDX) + (size_t)t * 128; const float* cf = wsp<float>(P, O_GATE) + (size_t)t * 128; const bf16_t* V = wsp<bf16_t>(P, O_VB);
    float y = 0.f;
    for (int k = 0; k < 128; ++k) y += cf[k] * bf2f(V[(size_t)ei[k] * D_ + n]);
    const float h2 = wsp<float>(P, O_H)[idx] + y;
    wsp<float>(P, O_H)[idx] = h2; wsp<bf16_t>(P, O_HG)[idx] = f2bf(h2 * P.g_ple[n]);
}
__global__ void __launch_bounds__(256) n_rstd2(Params P) {
    const long t = (long)blockIdx.x * 256 + threadIdx.x; if (t >= T_) return;
    const float* h = wsp<float>(P, O_H) + t * D_; float s = 0.f; for (int i = 0; i < D_; ++i) s += h[i] * h[i];
    wsp<float>(P, O_RSTD2)[t] = rsqrtf(s * (1.0f / D_) + EPS_);
}
__global__ void __launch_bounds__(256) n_ple(Params P) {
    const long idx = (long)blockIdx.x * 256 + threadIdx.x; if (idx >= (long)T_ * 1024) return;
    const int n = (int)(idx & 1023), t = (int)(idx >> 10);
    const float ga = wsp<float>(P, O_RSTD2)[t] * ndot(wsp<bf16_t>(P, O_HG) + (size_t)t * D_, wsp<bf16_t>(P, O_WPG) + (size_t)n * D_, D_);
    const float pr = ndot(wsp<bf16_t>(P, O_PB) + (size_t)t * 256, wsp<bf16_t>(P, O_WPP) + (size_t)n * 256, 256);
    P.out[idx] = wsp<float>(P, O_H)[idx] + pr / (1.0f + __expf(-ga));
}
__device__ void final_rows(const Params& P, long gwave, long gwaves, int lane) {
    for (long t = gwave; t < T_; t += gwaves) {
        const float rs = rstd_from(wsp<float>(P, O_SSQ3) + (size_t)t * 16, 16, 1.0f / 1024.0f);
        float* o = P.out + (size_t)t * D_;
#pragma unroll
        for (int i = 0; i < 4; ++i) { f32x4 v = *(f32x4*)(o + i * 256 + lane * 4); const f32x4 g = *(const f32x4*)(P.g_final + i * 256 + lane * 4);
            v[0] *= rs * g[0]; v[1] *= rs * g[1]; v[2] *= rs * g[2]; v[3] *= rs * g[3]; *(f32x4*)(o + i * 256 + lane * 4) = v; }
    }
}
__global__ void __launch_bounds__(256) k_final(Params P) { final_rows(P, ((long)blockIdx.x * 256 + threadIdx.x) >> 6, ((long)gridDim.x * 256) >> 6, threadIdx.x & 63); }

__global__ void __launch_bounds__(256) n_copy_h(Params P) { const long idx = (long)blockIdx.x * 256 + threadIdx.x; if (idx < (long)T_ * 1024) P.out[idx] = wsp<float>(P, O_H)[idx]; }
static inline int nblk(long n) { return (int)((n + 255) / 256); }

extern "C" void kernel_launch(void* const* d_in, const int* in_sizes, int n_in, void* d_out, int out_size, void* d_ws, size_t ws_size, hipStream_t stream) {
    if (ws_size < WS_NEED) { fprintf(stderr, "workspace too small: %zu < %zu\n", ws_size, (size_t)WS_NEED); return; }
    Params P{};
    const float** f = (const float**)&P;
    for (int i = 0; i < 21; ++i) f[i] = (const float*)d_in[i];
    P.out = (float*)d_out; P.ws = (unsigned char*)d_ws;

    k_prep<<<2048, 256, 0, stream>>>(P);
    n_gemm1<<<nblk((long)T_ * C_END), 256, 0, stream>>>(P);
    n_ssq_bf16<<<nblk((long)T_ * 6), 256, 0, stream>>>(P, 0);
    n_ssq_bf16<<<nblk((long)T_ * 4), 256, 0, stream>>>(P, 1);
    n_qup<<<nblk((long)T_ * 768), 256, 0, stream>>>(P);
    n_kvup<<<nblk((long)T_ * 1024), 256, 0, stream>>>(P);
    n_mla<<<nblk((long)T_ * 32), 256, 0, stream>>>(P);
    n_ssq_bf16<<<nblk((long)T_ * 8), 256, 0, stream>>>(P, 2);
    n_dil<<<nblk(3L * T_ * 32), 256, 0, stream>>>(P);
    k_merge<<<1024, 256, 0, stream>>>(P);
    n_outproj<<<nblk((long)T_ * 1024), 256, 0, stream>>>(P);
    n_ssq_f32<<<nblk((long)T_ * 16), 256, 0, stream>>>(P, 0);
    k_prep_tables<<<2048, 256, 0, stream>>>(P);
    n_peerq<<<nblk((long)T_ * 1024), 256, 0, stream>>>(P);
    n_topk1<<<nblk((long)T_ * 16), 256, 0, stream>>>(P);
    n_topk2<<<nblk((long)T_ * 8), 256, 0, stream>>>(P);
    n_peer_a<<<nblk((long)T_ * 128), 256, 0, stream>>>(P);
    n_peer_b<<<nblk((long)T_ * 1024), 256, 0, stream>>>(P);
    n_rstd2<<<nblk(T_), 256, 0, stream>>>(P);
    n_ple<<<nblk((long)T_ * 1024), 256, 0, stream>>>(P);
    n_ssq_f32<<<nblk((long)T_ * 16), 256, 0, stream>>>(P, 1);
    k_final<<<1024, 256, 0, stream>>>(P);
}
```

```cpp
#include <hip/hip_runtime.h>
#include <stdint.h>
#include <cstdio>

typedef unsigned short bf16_t;
typedef short bf16x8 __attribute__((ext_vector_type(8)));
typedef float f32x4 __attribute__((ext_vector_type(4)));
typedef unsigned u32x4 __attribute__((ext_vector_type(4)));
typedef unsigned u32x2 __attribute__((ext_vector_type(2)));

constexpr int T_ = 16384, S_ = 2048, NB_ = 8, D_ = 1024;
constexpr int NIN = 2304;
constexpr int C_QD = 0, C_KD = 512, C_VD = 1024, C_CQ = 1536, C_CKV = 1920, C_KR = 2176, C_END = 2208;
constexpr float EPS_ = 1e-6f;
constexpr float LOG2E = 1.4426950408889634f;
constexpr float QS_MLA = 0.10206207261596577f * LOG2E;
constexpr float QS_DIL = 0.125f * LOG2E;

constexpr size_t MiB = 1ull << 20;
constexpr size_t O_BAR   = 0;
constexpr size_t O_WIN   = 1 * MiB;
constexpr size_t O_WUQ   = 6 * MiB;
constexpr size_t O_WUKV  = 7 * MiB;
constexpr size_t O_WOUT  = 8 * MiB;
constexpr size_t O_WPQ   = 10 * MiB;
constexpr size_t O_WPG   = 12 * MiB;
constexpr size_t O_WPP   = 14 * MiB;
constexpr size_t O_K1B   = 14 * MiB + 512 * 1024;
constexpr size_t O_K2B   = O_K1B + 16384;
constexpr size_t O_COSM  = 15 * MiB;
constexpr size_t O_SINM  = O_COSM + 131072;
constexpr size_t O_COSD  = O_SINM + 131072;
constexpr size_t O_SIND  = O_COSD + 65536;
constexpr size_t O_RSTDX = O_SIND + 65536;
constexpr size_t O_SSQQ  = 16 * MiB;
constexpr size_t O_SSQKV = O_SSQQ + (size_t)T_ * 6 * 4;
constexpr size_t O_SSMLA = 17 * MiB;
constexpr size_t O_LSE   = 18 * MiB;
constexpr size_t O_SSQH  = 20 * MiB;
constexpr size_t O_RSTD2 = 21 * MiB;
constexpr size_t O_SSQ3  = 21 * MiB + 512 * 1024;
constexpr size_t O_PB    = 23 * MiB;
constexpr size_t O_D     = 31 * MiB;
constexpr size_t O_XB    = O_D;
constexpr size_t O_MIXED = O_D;
constexpr size_t O_CQ    = O_D + 32 * MiB;
constexpr size_t O_CKV   = O_D + 44 * MiB;
constexpr size_t O_QD    = O_D + 52 * MiB;
constexpr size_t O_KD    = O_D + 68 * MiB;
constexpr size_t O_VTD   = O_D + 84 * MiB;
constexpr size_t O_QM    = O_D + 132 * MiB;
constexpr size_t O_KM    = O_D + 156 * MiB;
constexpr size_t O_VTM   = O_D + 180 * MiB;
constexpr size_t O_H     = O_D + 52 * MiB;
constexpr size_t O_HG    = O_D + 116 * MiB;
constexpr size_t O_UB    = O_D + 148 * MiB;
constexpr size_t O_VB    = O_D + 180 * MiB;
constexpr size_t O_EIDX  = O_D + 212 * MiB;
constexpr size_t O_GATE  = O_D + 216 * MiB;
constexpr size_t WS_NEED = 256 * MiB;
constexpr size_t O_NV1   = O_D + 16 * MiB;
constexpr size_t O_NI1   = O_D + 24 * MiB;
constexpr size_t O_NV2   = O_D + 32 * MiB;
constexpr size_t O_NI2   = O_D + 40 * MiB;

struct Params {
    const float *x, *p, *g_mix, *w_in, *g_cq, *w_uq, *g_ckv, *w_ukv, *g_out_mla, *g_out_dil, *w_out, *g_ffn, *w_peer_q,
        *keys1, *keys2, *peer_u, *peer_v, *g_ple, *w_ple_gate, *w_ple_proj, *g_final;
    float* out;
    unsigned char* ws;
};

__device__ __forceinline__ bf16_t f2bf(float f) { unsigned u = __float_as_uint(f); u += 0x7fffu + ((u >> 16) & 1u); return (bf16_t)(u >> 16); }
__device__ __forceinline__ float bf2f(bf16_t b) { return __uint_as_float(((unsigned)b) << 16); }
__device__ __forceinline__ unsigned pack2(float a, float b) { return (unsigned)f2bf(a) | ((unsigned)f2bf(b) << 16); }
__device__ __forceinline__ float bflo(unsigned w) { return __uint_as_float(w << 16); }
__device__ __forceinline__ float bfhi(unsigned w) { return __uint_as_float(w & 0xffff0000u); }
__device__ __forceinline__ float wave_sum(float v) {
#pragma unroll
    for (int o = 32; o >= 1; o >>= 1) v += __shfl_xor(v, o);
    return v;
}
template <typename Tp> __host__ __device__ __forceinline__ Tp* wsp(const Params& P, size_t off) { return (Tp*)(P.ws + off); }

__device__ __forceinline__ int dil_of(int p) { return p == 0 ? 1 : (p == 1 ? 4 : 16); }
__device__ __forceinline__ int respos(int s, int dil) { return (s % dil) * (S_ / dil) + s / dil; }

__device__ __forceinline__ int win_src_col(int n) {
    if (n < 512) return 672 + n;
    if (n < 1024) return 1184 + (n - 512);
    if (n < 1536) return 1696 + (n - 1024);
    if (n < 1920) return n - 1536;
    if (n < 2176) return 384 + (n - 1920);
    if (n < 2208) return 640 + (n - 2176);
    return -1;
}
__device__ __forceinline__ void wt_job(const float* __restrict__ W, int Nsrc, int K, int srccol, const float* __restrict__ g0, const float* __restrict__ g1, int gsplit,
                                       bf16_t* __restrict__ Wt, int n, int k0) {
    unsigned w[4];
#pragma unroll
    for (int j = 0; j < 4; ++j) {
        float a = 0.f, b = 0.f;
        if (srccol >= 0) {
            const int ka = k0 + 2 * j, kb = ka + 1;
            a = W[(size_t)ka * Nsrc + srccol]; b = W[(size_t)kb * Nsrc + srccol];
            if (g0) { a *= (ka < gsplit ? g0[ka] : g1[ka - gsplit]); b *= (kb < gsplit ? g0[kb] : g1[kb - gsplit]); }
        }
        w[j] = pack2(a, b);
    }
    *(u32x4*)(Wt + (size_t)n * K + k0) = (u32x4){w[0], w[1], w[2], w[3]};
}

__device__ void prep_weights(const Params& P, long gtid, long gthreads) {
    for (long i = gtid; i < (long)NIN * 128; i += gthreads) { const int n = (int)(i % NIN), kc = (int)(i / NIN);
        wt_job(P.w_in, 2208, 1024, win_src_col(n), P.g_mix, P.g_mix, 1 << 30, wsp<bf16_t>(P, O_WIN), n, kc * 8); }
    for (long i = gtid; i < 768L * 48; i += gthreads) { const int n = (int)(i % 768), kc = (int)(i / 768);
        wt_job(P.w_uq, 768, 384, n, P.g_cq, P.g_cq, 1 << 30, wsp<bf16_t>(P, O_WUQ), n, kc * 8); }
    for (long i = gtid; i < 1024L * 32; i += gthreads) { const int n = (int)(i % 1024), kc = (int)(i / 1024);
        wt_job(P.w_ukv, 1024, 256, n, P.g_ckv, P.g_ckv, 1 << 30, wsp<bf16_t>(P, O_WUKV), n, kc * 8); }
    for (long i = gtid; i < 1024L * 128; i += gthreads) { const int n = (int)(i % 1024), kc = (int)(i / 1024);
        wt_job(P.w_out, 1024, 1024, n, P.g_out_mla, P.g_out_dil, 512, wsp<bf16_t>(P, O_WOUT), n, kc * 8);
        wt_job(P.w_peer_q, 1024, 1024, n, nullptr, nullptr, 0, wsp<bf16_t>(P, O_WPQ), n, kc * 8);
        wt_job(P.w_ple_gate, 1024, 1024, n, nullptr, nullptr, 0, wsp<bf16_t>(P, O_WPG), n, kc * 8); }
    for (long i = gtid; i < 1024L * 32; i += gthreads) { const int n = (int)(i % 1024), kc = (int)(i / 1024);
        wt_job(P.w_ple_proj, 1024, 256, n, nullptr, nullptr, 0, wsp<bf16_t>(P, O_WPP), n, kc * 8); }
    for (long i = gtid; i < 128L * 64; i += gthreads) { wsp<bf16_t>(P, O_K1B)[i] = f2bf(P.keys1[i]); wsp<bf16_t>(P, O_K2B)[i] = f2bf(P.keys2[i]); }
    for (long i = gtid; i < 2048L * 16; i += gthreads) { const int s = (int)(i >> 4), j = (int)(i & 15);
        const float inv = powf(500000.0f, -(float)(2 * j) / 32.0f); const float ang = (float)s * inv; float sn, cs; sincosf(ang, &sn, &cs);
        wsp<float>(P, O_COSM)[i] = cs; wsp<float>(P, O_SINM)[i] = sn; }
    for (long i = gtid; i < 2048L * 8; i += gthreads) { const int s = (int)(i >> 3), j = (int)(i & 7);
        const float inv = powf(500000.0f, -(float)(2 * j) / 16.0f); const float ang = (float)s * inv; float sn, cs; sincosf(ang, &sn, &cs);
        wsp<float>(P, O_COSD)[i] = cs; wsp<float>(P, O_SIND)[i] = sn; }
}
__device__ void prep_rows(const Params& P, long gwave, long gwaves, int lane) {
    for (long t = gwave; t < T_; t += gwaves) {
        const float* xr = P.x + (size_t)t * D_;
        float ss = 0.f; f32x4 v[4];
#pragma unroll
        for (int i = 0; i < 4; ++i) { v[i] = *(const f32x4*)(xr + i * 256 + lane * 4); ss += v[i][0] * v[i][0] + v[i][1] * v[i][1] + v[i][2] * v[i][2] + v[i][3] * v[i][3]; }
        ss = wave_sum(ss);
        bf16_t* xb = wsp<bf16_t>(P, O_XB) + (size_t)t * D_;
#pragma unroll
        for (int i = 0; i < 4; ++i) *(u32x2*)(xb + i * 256 + lane * 4) = (u32x2){pack2(v[i][0], v[i][1]), pack2(v[i][2], v[i][3])};
        if (lane == 0) wsp<float>(P, O_RSTDX)[t] = rsqrtf(ss * (1.0f / D_) + EPS_);
        const f32x4 pv = *(const f32x4*)(P.p + (size_t)t * 256 + lane * 4);
        *(u32x2*)(wsp<bf16_t>(P, O_PB) + (size_t)t * 256 + lane * 4) = (u32x2){pack2(pv[0], pv[1]), pack2(pv[2], pv[3])};
    }
}
__device__ void prep_tables(const Params& P, long gtid, long gthreads) {
    const long n8 = 16384L * 1024 / 8;
    for (long i = gtid; i < n8; i += gthreads) {
        const f32x4 a = *(const f32x4*)(P.peer_u + i * 8), b = *(const f32x4*)(P.peer_u + i * 8 + 4);
        *(u32x4*)(wsp<bf16_t>(P, O_UB) + i * 8) = (u32x4){pack2(a[0], a[1]), pack2(a[2], a[3]), pack2(b[0], b[1]), pack2(b[2], b[3])};
        const f32x4 c = *(const f32x4*)(P.peer_v + i * 8), d = *(const f32x4*)(P.peer_v + i * 8 + 4);
        *(u32x4*)(wsp<bf16_t>(P, O_VB) + i * 8) = (u32x4){pack2(c[0], c[1]), pack2(c[2], c[3]), pack2(d[0], d[1]), pack2(d[2], d[3])};
    }
}

__global__ void __launch_bounds__(256) k_prep(Params P) {
    const long gtid = (long)blockIdx.x * 256 + threadIdx.x, gthreads = (long)gridDim.x * 256;
    prep_weights(P, gtid, gthreads);
    prep_rows(P, gtid >> 6, gthreads >> 6, threadIdx.x & 63);
}
__global__ void __launch_bounds__(256) k_prep_tables(Params P) {
    prep_tables(P, (long)blockIdx.x * 256 + threadIdx.x, (long)gridDim.x * 256);
}

__device__ __forceinline__ float ndot(const bf16_t* __restrict__ a, const bf16_t* __restrict__ b, int K) {
    float acc = 0.f;
    for (int k = 0; k < K; k += 8) {
        const u32x4 x = *(const u32x4*)(a + k), y = *(const u32x4*)(b + k);
#pragma unroll
        for (int j = 0; j < 4; ++j) acc += bflo(x[j]) * bflo(y[j]) + bfhi(x[j]) * bfhi(y[j]);
    }
    return acc;
}
__global__ void __launch_bounds__(256) n_gemm1(Params P) {
    const long idx = (long)blockIdx.x * 256 + threadIdx.x; if (idx >= (long)T_ * C_END) return;
    const int n = (int)(idx % C_END), t = (int)(idx / C_END), b = t / S_, s = t % S_;
    const bf16_t* xb = wsp<bf16_t>(P, O_XB) + (size_t)t * D_; const bf16_t* W = wsp<bf16_t>(P, O_WIN);
    const float rs = wsp<float>(P, O_RSTDX)[t];
    float v = rs * ndot(xb, W + (size_t)n * D_, D_);
    if (n < C_VD) {
        const bool isq = n < C_KD; const int c = isq ? n : n - C_KD, h = c >> 6, d = c & 63;
        if (d < 16) { const int pn = d < 8 ? n + 8 : n - 8; const float pv = rs * ndot(xb, W + (size_t)pn * D_, D_);
            const float cs = wsp<float>(P, O_COSD)[s * 8 + (d & 7)], sn = wsp<float>(P, O_SIND)[s * 8 + (d & 7)];
            v = d < 8 ? v * cs - pv * sn : v * cs + pv * sn; }
        if (isq) v *= QS_DIL;
        wsp<bf16_t>(P, isq ? O_QD : O_KD)[(((size_t)b * 8 + h) * S_ + s) * 64 + d] = f2bf(v);
    } else if (n < C_CQ) {
        const int c = n - C_VD, h = c >> 6, d = c & 63;
        for (int p = 0; p < 3; ++p) wsp<bf16_t>(P, O_VTD)[(size_t)p * T_ * 512 + (((size_t)b * 8 + h) * 64 + d) * S_ + respos(s, dil_of(p))] = f2bf(v);
    } else if (n < C_CKV) { wsp<bf16_t>(P, O_CQ)[(size_t)t * 384 + (n - C_CQ)] = f2bf(v);
    } else if (n < C_KR) { wsp<bf16_t>(P, O_CKV)[(size_t)t * 256 + (n - C_CKV)] = f2bf(v);
    } else {
        const int j = n - C_KR; const int pn = j < 16 ? n + 16 : n - 16; const float pv = rs * ndot(xb, W + (size_t)pn * D_, D_);
        const float cs = wsp<float>(P, O_COSM)[s * 16 + (j & 15)], sn = wsp<float>(P, O_SINM)[s * 16 + (j & 15)];
        v = j < 16 ? v * cs - pv * sn : v * cs + pv * sn;
        for (int h = 0; h < 8; ++h) wsp<bf16_t>(P, O_KM)[(((size_t)b * 8 + h) * S_ + s) * 96 + 64 + j] = f2bf(v);
    }
}
__global__ void __launch_bounds__(256) n_ssq_bf16(Params P, int sel) {
    const bf16_t* buf = sel == 0 ? wsp<bf16_t>(P, O_CQ) : (sel == 1 ? wsp<bf16_t>(P, O_CKV) : (const bf16_t*)P.out);
    float* out = wsp<float>(P, sel == 0 ? O_SSQQ : (sel == 1 ? O_SSQKV : O_SSMLA));
    const int ld = sel == 0 ? 384 : (sel == 1 ? 256 : 512), ngran = ld / 64;
    const long idx = (long)blockIdx.x * 256 + threadIdx.x; if (idx >= (long)T_ * ngran) return;
    const int g = (int)(idx % ngran), t = (int)(idx / ngran); float s = 0.f;
    for (int j = 0; j < 64; ++j) { const float v = bf2f(buf[(size_t)t * ld + g * 64 + j]); s += v * v; }
    out[idx] = s;
}
__global__ void __launch_bounds__(256) n_ssq_f32(Params P, int sel) {
    const float* buf = sel == 0 ? wsp<float>(P, O_H) : P.out; float* out = wsp<float>(P, sel == 0 ? O_SSQH : O_SSQ3);
    const int ld = 1024, ngran = 16;
    const long idx = (long)blockIdx.x * 256 + threadIdx.x; if (idx >= (long)T_ * ngran) return;
    const int g = (int)(idx % ngran), t = (int)(idx / ngran); float s = 0.f;
    for (int j = 0; j < 64; ++j) { const float v = buf[(size_t)t * ld + g * 64 + j]; s += v * v; }
    out[idx] = s;
}
__device__ __forceinline__ float rstd_from(const float* part, int n, float invdim) { float s = 0.f; for (int i = 0; i < n; ++i) s += part[i]; return rsqrtf(s * invdim + EPS_); }
__global__ void __launch_bounds__(256) n_qup(Params P) {
    const long idx = (long)blockIdx.x * 256 + threadIdx.x; if (idx >= (long)T_ * 768) return;
    const int n = (int)(idx % 768), t = (int)(idx / 768), b = t / S_, s = t % S_;
    const bf16_t* a = wsp<bf16_t>(P, O_CQ) + (size_t)t * 384; const bf16_t* W = wsp<bf16_t>(P, O_WUQ);
    const float rs = rstd_from(wsp<float>(P, O_SSQQ) + (size_t)t * 6, 6, 1.0f / 384.0f);
    float v = rs * ndot(a, W + (size_t)n * 384, 384);
    const int h = n / 96, d = n % 96;
    if (d >= 64) { const int j = d - 64; const int pn = j < 16 ? n + 16 : n - 16; const float pv = rs * ndot(a, W + (size_t)pn * 384, 384);
        const float cs = wsp<float>(P, O_COSM)[s * 16 + (j & 15)], sn = wsp<float>(P, O_SINM)[s * 16 + (j & 15)];
        v = j < 16 ? v * cs - pv * sn : v * cs + pv * sn; }
    wsp<bf16_t>(P, O_QM)[(((size_t)b * 8 + h) * S_ + s) * 96 + d] = f2bf(v * QS_MLA);
}
__global__ void __launch_bounds__(256) n_kvup(Params P) {
    const long idx = (long)blockIdx.x * 256 + threadIdx.x; if (idx >= (long)T_ * 1024) return;
    const int n = (int)(idx % 1024), t = (int)(idx / 1024), b = t / S_, s = t % S_;
    const bf16_t* a = wsp<bf16_t>(P, O_CKV) + (size_t)t * 256; const bf16_t* W = wsp<bf16_t>(P, O_WUKV);
    const float rs = rstd_from(wsp<float>(P, O_SSQKV) + (size_t)t * 4, 4, 1.0f / 256.0f);
    const float v = rs * ndot(a, W + (size_t)n * 256, 256);
    const int h = n >> 7, d = n & 127;
    if (d < 64) wsp<bf16_t>(P, O_KM)[(((size_t)b * 8 + h) * S_ + s) * 96 + d] = f2bf(v);
    else wsp<bf16_t>(P, O_VTM)[(((size_t)b * 8 + h) * 64 + (d - 64)) * S_ + s] = f2bf(v);
}
__global__ void __launch_bounds__(256) n_mla(Params P) {
    bf16_t* omla = (bf16_t*)P.out;
    const long idx = (long)blockIdx.x * 256 + threadIdx.x; if (idx >= (long)T_ * 8 * 4) return;
    const int dq = (int)(idx & 3); const long r = idx >> 2; const int s = (int)(r % S_); const int bh = (int)(r / S_);
    const bf16_t* q = wsp<bf16_t>(P, O_QM) + ((size_t)bh * S_ + s) * 96; const bf16_t* K = wsp<bf16_t>(P, O_KM) + (size_t)bh * S_ * 96;
    const bf16_t* Vt = wsp<bf16_t>(P, O_VTM) + (size_t)bh * 64 * S_;
    float m = -1e30f;
    for (int k = 0; k < S_; ++k) m = fmaxf(m, ndot(q, K + (size_t)k * 96, 96));
    float l = 0.f, o[16];
#pragma unroll
    for (int i = 0; i < 16; ++i) o[i] = 0.f;
    for (int k = 0; k < S_; ++k) { const float pw = exp2f(ndot(q, K + (size_t)k * 96, 96) - m); l += pw;
#pragma unroll
        for (int i = 0; i < 16; ++i) o[i] += pw * bf2f(Vt[(size_t)(dq * 16 + i) * S_ + k]); }
    const int b = bh >> 3, h = bh & 7; const float il = 1.0f / l;
#pragma unroll
    for (int i = 0; i < 16; ++i) omla[((size_t)b * S_ + s) * 512 + h * 64 + dq * 16 + i] = f2bf(o[i] * il);
}
__global__ void __launch_bounds__(256) n_dil(Params P) {
    bf16_t* opart = (bf16_t*)P.out + (size_t)T_ * 512;
    const long idx = (long)blockIdx.x * 256 + threadIdx.x; if (idx >= 3L * T_ * 8 * 4) return;
    const int dq = (int)(idx & 3); long r = idx >> 2; const int s = (int)(r % S_); r /= S_; const int bh = (int)(r % 64); const int p = (int)(r / 64);
    const int dil = dil_of(p);
    const bf16_t* q = wsp<bf16_t>(P, O_QD) + ((size_t)bh * S_ + s) * 64; const bf16_t* K = wsp<bf16_t>(P, O_KD) + (size_t)bh * S_ * 64;
    const bf16_t* Vt = wsp<bf16_t>(P, O_VTD) + (size_t)p * T_ * 512 + (size_t)bh * 64 * S_;
    float m = -1e30f;
    for (int i = -64; i <= 64; ++i) { const int kp = s + i * dil; if (kp < 0 || kp >= S_) continue; m = fmaxf(m, ndot(q, K + (size_t)kp * 64, 64)); }
    float l = 0.f, o[16];
#pragma unroll
    for (int i = 0; i < 16; ++i) o[i] = 0.f;
    for (int i = -64; i <= 64; ++i) { const int kp = s + i * dil; if (kp < 0 || kp >= S_) continue;
        const float pw = exp2f(ndot(q, K + (size_t)kp * 64, 64) - m); l += pw; const int rp = respos(kp, dil);
#pragma unroll
        for (int j = 0; j < 16; ++j) o[j] += pw * bf2f(Vt[(size_t)(dq * 16 + j) * S_ + rp]); }
    const int b = bh >> 3, h = bh & 7; const size_t t = (size_t)b * S_ + s; const float il = 1.0f / l;
#pragma unroll
    for (int j = 0; j < 16; ++j) opart[(size_t)p * T_ * 512 + t * 512 + h * 64 + dq * 16 + j] = f2bf(o[j] * il);
    if (dq == 0) wsp<float>(P, O_LSE)[((size_t)p * T_ + t) * 8 + h] = m + log2f(l);
}
__device__ void merge_rows(const Params& P, const bf16_t* omla, const bf16_t* opart, long gwave, long gwaves, int lane) {
    for (long t = gwave; t < T_; t += gwaves) {
        const int h = lane >> 3;
        const float* lse = wsp<float>(P, O_LSE);
        const float l0 = lse[((size_t)0 * T_ + t) * 8 + h], l1 = lse[((size_t)1 * T_ + t) * 8 + h], l2 = lse[((size_t)2 * T_ + t) * 8 + h];
        const float mx = fmaxf(l0, fmaxf(l1, l2)); float w0 = exp2f(l0 - mx), w1 = exp2f(l1 - mx), w2 = exp2f(l2 - mx); const float iw = 1.0f / (w0 + w1 + w2); w0 *= iw; w1 *= iw; w2 *= iw;
        const u32x4 a0 = *(const u32x4*)(opart + (size_t)0 * T_ * 512 + (size_t)t * 512 + lane * 8), a1 = *(const u32x4*)(opart + (size_t)1 * T_ * 512 + (size_t)t * 512 + lane * 8),
                    a2 = *(const u32x4*)(opart + (size_t)2 * T_ * 512 + (size_t)t * 512 + lane * 8);
        float od[8]; float ssd = 0.f;
#pragma unroll
        for (int j = 0; j < 4; ++j) { od[2 * j] = w0 * bflo(a0[j]) + w1 * bflo(a1[j]) + w2 * bflo(a2[j]); od[2 * j + 1] = w0 * bfhi(a0[j]) + w1 * bfhi(a1[j]) + w2 * bfhi(a2[j]);
            ssd += od[2 * j] * od[2 * j] + od[2 * j + 1] * od[2 * j + 1]; }
        ssd = wave_sum(ssd); const float rd = rsqrtf(ssd * (1.0f / 512.0f) + EPS_);
        const float rm = rstd_from(wsp<float>(P, O_SSMLA) + (size_t)t * 8, 8, 1.0f / 512.0f);
        const u32x4 am = *(const u32x4*)(omla + (size_t)t * 512 + lane * 8);
        bf16_t* mx_ = wsp<bf16_t>(P, O_MIXED) + (size_t)t * D_;
        *(u32x4*)(mx_ + lane * 8) = (u32x4){pack2(bflo(am[0]) * rm, bfhi(am[0]) * rm), pack2(bflo(am[1]) * rm, bfhi(am[1]) * rm), pack2(bflo(am[2]) * rm, bfhi(am[2]) * rm), pack2(bflo(am[3]) * rm, bfhi(am[3]) * rm)};
        *(u32x4*)(mx_ + 512 + lane * 8) = (u32x4){pack2(od[0] * rd, od[1] * rd), pack2(od[2] * rd, od[3] * rd), pack2(od[4] * rd, od[5] * rd), pack2(od[6] * rd, od[7] * rd)};
    }
}
__global__ void __launch_bounds__(256) k_merge(Params P) {
    merge_rows(P, (const bf16_t*)P.out, (const bf16_t*)P.out + (size_t)T_ * 512, ((long)blockIdx.x * 256 + threadIdx.x) >> 6, ((long)gridDim.x * 256) >> 6, threadIdx.x & 63);
}
__global__ void __launch_bounds__(256) n_outproj(Params P) {
    const long idx = (long)blockIdx.x * 256 + threadIdx.x; if (idx >= (long)T_ * 1024) return;
    const int n = (int)(idx & 1023), t = (int)(idx >> 10);
    const float v = ndot(wsp<bf16_t>(P, O_MIXED) + (size_t)t * D_, wsp<bf16_t>(P, O_WOUT) + (size_t)n * D_, D_) + P.x[idx];
    wsp<float>(P, O_H)[idx] = v; wsp<bf16_t>(P, O_HG)[idx] = f2bf(v * P.g_ffn[n]);
}
__global__ void __launch_bounds__(256) n_peerq(Params P) {
    float* qf = P.out;
    const long idx = (long)blockIdx.x * 256 + threadIdx.x; if (idx >= (long)T_ * 1024) return;
    const int n = (int)(idx & 1023), t = (int)(idx >> 10);
    const float rs = rstd_from(wsp<float>(P, O_SSQH) + (size_t)t * 16, 16, 1.0f / 1024.0f);
    qf[idx] = rs * ndot(wsp<bf16_t>(P, O_HG) + (size_t)t * D_, wsp<bf16_t>(P, O_WPQ) + (size_t)n * D_, D_);
}
__global__ void __launch_bounds__(256) n_topk1(Params P) {
    const long idx = (long)blockIdx.x * 256 + threadIdx.x; if (idx >= (long)T_ * 16) return;
    const int half = (int)(idx & 1); const long th = idx >> 1;
    const int t_ = (int)(th >> 3), h_ = (int)(th & 7);
    const float* q = P.out + (size_t)t_ * 1024 + h_ * 128 + half * 64; const float* keys = half ? P.keys2 : P.keys1;
    float* vo = wsp<float>(P, half ? O_NV2 : O_NV1) + th * 16; int* io = wsp<int>(P, half ? O_NI2 : O_NI1) + th * 16;
    float pv = 3e38f; int pi = -1;
    for (int r = 0; r < 16; ++r) { float bv = -3e38f; int bi = 0;
        for (int k = 0; k < 128; ++k) { float v = 0.f; for (int d = 0; d < 64; ++d) v += q[d] * keys[k * 64 + d]; const bool elig = (v < pv) || (v == pv && k > pi); if (elig && (v > bv)) { bv = v; bi = k; } }
        vo[r] = bv; io[r] = bi; pv = bv; pi = bi; }
}
__global__ void __launch_bounds__(256) n_topk2(Params P) {
    const long th = (long)blockIdx.x * 256 + threadIdx.x; if (th >= (long)T_ * 8) return;
    const float* v1 = wsp<float>(P, O_NV1) + th * 16; const float* v2 = wsp<float>(P, O_NV2) + th * 16;
    const int* i1 = wsp<int>(P, O_NI1) + th * 16; const int* i2 = wsp<int>(P, O_NI2) + th * 16;
    unsigned short* eo = wsp<unsigned short>(P, O_EIDX) + th * 16; float* go = wsp<float>(P, O_GATE) + th * 16;
    float pv = 3e38f; int pi = -1; float top0 = 0.f, den = 0.f;
    for (int r = 0; r < 16; ++r) { float bv = -3e38f; int bi = 0;
        for (int c = 0; c < 256; ++c) { const float v = v1[c >> 4] + v2[c & 15]; const bool elig = (v < pv) || (v == pv && c > pi); if (elig && (v > bv)) { bv = v; bi = c; } }
        if (r == 0) top0 = bv; const float e = __expf(bv - top0); den += e; go[r] = e; eo[r] = (unsigned short)(i1[bi >> 4] * 128 + i2[bi & 15]); pv = bv; pi = bi; }
    const float id = 1.0f / den;
    for (int r = 0; r < 16; ++r) go[r] *= id;
}
__global__ void __launch_bounds__(256) n_peer_a(Params P) {
    const long idx = (long)blockIdx.x * 256 + threadIdx.x; if (idx >= (long)T_ * 128) return;
    const int t = (int)(idx >> 7);
    const float rs = rstd_from(wsp<float>(P, O_SSQH) + (size_t)t * 16, 16, 1.0f / 1024.0f);
    const int e = wsp<unsigned short>(P, O_EIDX)[idx];
    const float a = rs * ndot(wsp<bf16_t>(P, O_HG) + (size_t)t * D_, wsp<bf16_t>(P, O_UB) + (size_t)e * D_, D_);
    const float ge = 0.5f * a * (1.0f + erff(a * 0.70710678118654752f));
    wsp<float>(P, O_GATE)[idx] *= ge;
}
__global__ void __launch_bounds__(256) n_peer_b(Params P) {
    const long idx = (long)blockIdx.x * 256 + threadIdx.x; if (idx >= (long)T_ * 1024) return;
    const int n = (int)(idx & 1023), t = (int)(idx >> 10);
    const unsigned short* ei = wsp<unsigned short>(P, O_EIDX) + (size_t)t * 128; const float* cf = wsp<float>(P, O_GATE) + (size_t)t * 128; const bf16_t* V = wsp<bf16_t>(P, O_VB);
    float y = 0.f;
    for (int k = 0; k < 128; ++k) y += cf[k] * bf2f(V[(size_t)ei[k] * D_ + n]);
    const float h2 = wsp<float>(P, O_H)[idx] + y;
    wsp<float>(P, O_H)[idx] = h2; wsp<bf16_t>(P, O_HG)[idx] = f2bf(h2 * P.g_ple[n]);
}
__global__ void __launch_bounds__(256) n_rstd2(Params P) {
    const long t = (long)blockIdx.x * 256 + threadIdx.x; if (t >= T_) return;
    const float* h = wsp<float>(P, O_H) + t * D_; float s = 0.f; for (int i = 0; i < D_; ++i) s += h[i] * h[i];
    wsp<float>(P, O_RSTD2)[t] = rsqrtf(s * (1.0f / D_) + EPS_);
}
__global__ void __launch_bounds__(256) n_ple(Params P) {
    const long idx = (long)blockIdx.x * 256 + threadIdx.x; if (idx >= (long)T_ * 1024) return;
    const int n = (int)(idx & 1023), t = (int)(idx >> 10);
    const float ga = wsp<float>(P, O_RSTD2)[t] * ndot(wsp<bf16_t>(P, O_HG) + (size_t)t * D_, wsp<bf16_t>(P, O_WPG) + (size_t)n * D_, D_);
    const float pr = ndot(wsp<bf16_t>(P, O_PB) + (size_t)t * 256, wsp<bf16_t>(P, O_WPP) + (size_t)n * 256, 256);
    P.out[idx] = wsp<float>(P, O_H)[idx] + pr / (1.0f + __expf(-ga));
}
__device__ void final_rows(const Params& P, long gwave, long gwaves, int lane) {
    for (long t = gwave; t < T_; t += gwaves) {
        const float rs = rstd_from(wsp<float>(P, O_SSQ3) + (size_t)t * 16, 16, 1.0f / 1024.0f);
        float* o = P.out + (size_t)t * D_;
#pragma unroll
        for (int i = 0; i < 4; ++i) { f32x4 v = *(f32x4*)(o + i * 256 + lane * 4); const f32x4 g = *(const f32x4*)(P.g_final + i * 256 + lane * 4);
            v[0] *= rs * g[0]; v[1] *= rs * g[1]; v[2] *= rs * g[2]; v[3] *= rs * g[3]; *(f32x4*)(o + i * 256 + lane * 4) = v; }
    }
}
__global__ void __launch_bounds__(256) k_final(Params P) { final_rows(P, ((long)blockIdx.x * 256 + threadIdx.x) >> 6, ((long)gridDim.x * 256) >> 6, threadIdx.x & 63); }


#define MFMA16(a, b, c) __builtin_amdgcn_mfma_f32_16x16x32_bf16((a), (b), (c), 0, 0, 0)
constexpr int SMEM_BYTES = 65536;

__device__ __forceinline__ void gemm_acc(const bf16_t* __restrict__ A, int lda, const bf16_t* __restrict__ Bt, int ldb, int K,
                                         unsigned char* smem, f32x4 (&acc)[4][4], int tid) {
    const int lane = tid & 63, w = tid >> 6, wr = w >> 1, wc = w & 1, fr = lane & 15, fq = lane >> 4;
    const int srow = tid >> 3, sch = tid & 7;
    const bf16_t* ap = A + (size_t)srow * lda + sch * 8;
    const bf16_t* bp = Bt + (size_t)srow * ldb + sch * 8;
    const int soff = srow * 128 + ((sch ^ (srow & 7)) << 4);
    u32x4 ra[4], rb[4];
    const int nk = K >> 6;
#pragma unroll
    for (int i = 0; i < 4; ++i) { ra[i] = *(const u32x4*)(ap + (size_t)(32 * i) * lda); rb[i] = *(const u32x4*)(bp + (size_t)(32 * i) * ldb); }
#pragma unroll
    for (int i = 0; i < 4; ++i) { *(u32x4*)(smem + soff + i * 4096) = ra[i]; *(u32x4*)(smem + 16384 + soff + i * 4096) = rb[i]; }
    __syncthreads();
    const int aoff = (64 * wr + fr) * 128, boff = 16384 + (64 * wc + fr) * 128, sw = fr & 7;
    for (int kt = 0; kt < nk; ++kt) {
        const bool more = kt + 1 < nk;
        if (more) {
#pragma unroll
            for (int i = 0; i < 4; ++i) { ra[i] = *(const u32x4*)(ap + (size_t)(32 * i) * lda + (kt + 1) * 64); rb[i] = *(const u32x4*)(bp + (size_t)(32 * i) * ldb + (kt + 1) * 64); }
        }
        const unsigned char* sb = smem + (kt & 1) * 32768;
#pragma unroll
        for (int ks = 0; ks < 2; ++ks) {
            const int ch = ((ks * 4 + fq) ^ sw) << 4;
            bf16x8 af[4], bfr[4];
#pragma unroll
            for (int i = 0; i < 4; ++i) { af[i] = *(const bf16x8*)(sb + aoff + i * 2048 + ch); bfr[i] = *(const bf16x8*)(sb + boff + i * 2048 + ch); }
#pragma unroll
            for (int ni = 0; ni < 4; ++ni)
#pragma unroll
                for (int mi = 0; mi < 4; ++mi) acc[ni][mi] = MFMA16(bfr[ni], af[mi], acc[ni][mi]);
        }
        if (more) {
            unsigned char* sn = smem + ((kt + 1) & 1) * 32768;
#pragma unroll
            for (int i = 0; i < 4; ++i) { *(u32x4*)(sn + soff + i * 4096) = ra[i]; *(u32x4*)(sn + 16384 + soff + i * 4096) = rb[i]; }
        }
        __syncthreads();
    }
}
__device__ __forceinline__ void zero_acc(f32x4 (&acc)[4][4]) {
#pragma unroll
    for (int a = 0; a < 4; ++a)
#pragma unroll
        for (int b = 0; b < 4; ++b) acc[a][b] = (f32x4){0.f, 0.f, 0.f, 0.f};
}
__device__ __forceinline__ float quad_sum(float v) { v += __shfl_xor(v, 16); v += __shfl_xor(v, 32); return v; }
__device__ __forceinline__ u32x2 pack4(f32x4 v) { return (u32x2){pack2(v[0], v[1]), pack2(v[2], v[3])}; }

__device__ void p1_tile(const Params& P, int pm, int pn, unsigned char* smem, int tid) {
    f32x4 acc[4][4]; zero_acc(acc);
    gemm_acc(wsp<bf16_t>(P, O_XB) + (size_t)pm * 128 * D_, D_, wsp<bf16_t>(P, O_WIN) + (size_t)pn * 128 * D_, D_, D_, smem, acc, tid);
    const int lane = tid & 63, w = tid >> 6, wr = w >> 1, wc = w & 1, fr = lane & 15, fq = lane >> 4;
    const int ns = pn * 128 + wc * 64;
    if (ns >= C_KR + 64) return;
#pragma unroll
    for (int mi = 0; mi < 4; ++mi) {
        const int t = pm * 128 + wr * 64 + mi * 16 + fr, b = t >> 11, s = t & 2047;
        const float rs = wsp<float>(P, O_RSTDX)[t];
        if (ns < C_VD) {
            const bool isq = ns < C_KD; const int h = (isq ? ns : ns - C_KD) >> 6;
            bf16_t* dst = wsp<bf16_t>(P, isq ? O_QD : O_KD) + (((size_t)b * 8 + h) * S_ + s) * 64;
#pragma unroll
            for (int ni = 0; ni < 4; ++ni) {
                f32x4 v = acc[ni][mi] * rs;
                if (ni == 0) {
#pragma unroll
                    for (int r = 0; r < 4; ++r) { const float pv = __shfl_xor(v[r], 32); const int j = (4 * fq + r) & 7;
                        const float cs = wsp<float>(P, O_COSD)[s * 8 + j], sn = wsp<float>(P, O_SIND)[s * 8 + j];
                        v[r] = fq < 2 ? v[r] * cs - pv * sn : v[r] * cs + pv * sn; }
                }
                if (isq) v = v * QS_DIL;
                *(u32x2*)(dst + ni * 16 + 4 * fq) = pack4(v);
            }
        } else if (ns < C_CQ) {
            const int h = (ns - C_VD) >> 6;
#pragma unroll
            for (int ni = 0; ni < 4; ++ni) { const f32x4 v = acc[ni][mi] * rs;
#pragma unroll
                for (int r = 0; r < 4; ++r) { const int d = ni * 16 + 4 * fq + r; const bf16_t bv = f2bf(v[r]);
                    bf16_t* base = wsp<bf16_t>(P, O_VTD) + (((size_t)b * 8 + h) * 64 + d) * S_;
                    base[s] = bv; base[(size_t)T_ * 512 + respos(s, 4)] = bv; base[(size_t)2 * T_ * 512 + respos(s, 16)] = bv; } }
        } else if (ns < C_KR) {
            const bool isq = ns < C_CKV; const int c0 = isq ? ns - C_CQ : ns - C_CKV;
            bf16_t* dst = isq ? wsp<bf16_t>(P, O_CQ) + (size_t)t * 384 + c0 : wsp<bf16_t>(P, O_CKV) + (size_t)t * 256 + c0;
            float ss = 0.f;
#pragma unroll
            for (int ni = 0; ni < 4; ++ni) { const f32x4 v = acc[ni][mi] * rs; ss += v[0] * v[0] + v[1] * v[1] + v[2] * v[2] + v[3] * v[3]; *(u32x2*)(dst + ni * 16 + 4 * fq) = pack4(v); }
            ss = quad_sum(ss);
            if (fq == 0) { if (isq) wsp<float>(P, O_SSQQ)[(size_t)t * 6 + (c0 >> 6)] = ss; else wsp<float>(P, O_SSQKV)[(size_t)t * 4 + (c0 >> 6)] = ss; }
        } else {
            f32x4 x1 = acc[0][mi] * rs, x2 = acc[1][mi] * rs, o1, o2;
#pragma unroll
            for (int r = 0; r < 4; ++r) { const int j = 4 * fq + r; const float cs = wsp<float>(P, O_COSM)[s * 16 + j], sn = wsp<float>(P, O_SINM)[s * 16 + j];
                o1[r] = x1[r] * cs - x2[r] * sn; o2[r] = x2[r] * cs + x1[r] * sn; }
            const u32x2 w1 = pack4(o1), w2 = pack4(o2);
#pragma unroll
            for (int h = 0; h < 8; ++h) { bf16_t* dst = wsp<bf16_t>(P, O_KM) + (((size_t)b * 8 + h) * S_ + s) * 96 + 64 + 4 * fq; *(u32x2*)dst = w1; *(u32x2*)(dst + 16) = w2; }
        }
    }
}
__device__ void p2a_tile(const Params& P, int pm, int pn, unsigned char* smem, int tid) {
    f32x4 acc[4][4]; zero_acc(acc);
    gemm_acc(wsp<bf16_t>(P, O_CQ) + (size_t)pm * 128 * 384, 384, wsp<bf16_t>(P, O_WUQ) + (size_t)pn * 128 * 384, 384, 384, smem, acc, tid);
    const int lane = tid & 63, w = tid >> 6, wr = w >> 1, wc = w & 1, fr = lane & 15, fq = lane >> 4;
    const int ns = pn * 128 + wc * 64;
#pragma unroll
    for (int mi = 0; mi < 4; ++mi) {
        const int t = pm * 128 + wr * 64 + mi * 16 + fr, b = t >> 11, s = t & 2047;
        const float rs = rstd_from(wsp<float>(P, O_SSQQ) + (size_t)t * 6, 6, 1.0f / 384.0f) * QS_MLA;
#pragma unroll
        for (int ni = 0; ni < 4; ++ni) {
            const int c = ns + ni * 16, hq = c / 96, d0 = c - hq * 96;
            bf16_t* dst = wsp<bf16_t>(P, O_QM) + (((size_t)b * 8 + hq) * S_ + s) * 96;
            if (d0 < 64) { *(u32x2*)(dst + d0 + 4 * fq) = pack4(acc[ni][mi] * rs); }
            else if (d0 == 64 && ni < 3) {
                const f32x4 x1 = acc[ni][mi] * rs, x2 = acc[ni + 1 < 4 ? ni + 1 : 3][mi] * rs; f32x4 o1, o2;
#pragma unroll
                for (int r = 0; r < 4; ++r) { const int j = 4 * fq + r; const float cs = wsp<float>(P, O_COSM)[s * 16 + j], sn = wsp<float>(P, O_SINM)[s * 16 + j];
                    o1[r] = x1[r] * cs - x2[r] * sn; o2[r] = x2[r] * cs + x1[r] * sn; }
                *(u32x2*)(dst + 64 + 4 * fq) = pack4(o1); *(u32x2*)(dst + 80 + 4 * fq) = pack4(o2);
            }
        }
    }
}
__device__ void p2b_tile(const Params& P, int pm, int pn, unsigned char* smem, int tid) {
    f32x4 acc[4][4]; zero_acc(acc);
    gemm_acc(wsp<bf16_t>(P, O_CKV) + (size_t)pm * 128 * 256, 256, wsp<bf16_t>(P, O_WUKV) + (size_t)pn * 128 * 256, 256, 256, smem, acc, tid);
    const int lane = tid & 63, w = tid >> 6, wr = w >> 1, wc = w & 1, fr = lane & 15, fq = lane >> 4;
    const int h = pn;
#pragma unroll
    for (int mi = 0; mi < 4; ++mi) {
        const int t = pm * 128 + wr * 64 + mi * 16 + fr, b = t >> 11, s = t & 2047;
        const float rs = rstd_from(wsp<float>(P, O_SSQKV) + (size_t)t * 4, 4, 1.0f / 256.0f);
#pragma unroll
        for (int ni = 0; ni < 4; ++ni) {
            const f32x4 v = acc[ni][mi] * rs;
            if (wc == 0) { *(u32x2*)(wsp<bf16_t>(P, O_KM) + (((size_t)b * 8 + h) * S_ + s) * 96 + ni * 16 + 4 * fq) = pack4(v); }
            else {
#pragma unroll
                for (int r = 0; r < 4; ++r) wsp<bf16_t>(P, O_VTM)[(((size_t)b * 8 + h) * 64 + ni * 16 + 4 * fq + r) * S_ + s] = f2bf(v[r]);
            }
        }
    }
}
__device__ void p5_tile(const Params& P, int pm, int pn, unsigned char* smem, int tid) {
    f32x4 acc[4][4]; zero_acc(acc);
    gemm_acc(wsp<bf16_t>(P, O_MIXED) + (size_t)pm * 128 * D_, D_, wsp<bf16_t>(P, O_WOUT) + (size_t)pn * 128 * D_, D_, D_, smem, acc, tid);
    const int lane = tid & 63, w = tid >> 6, wr = w >> 1, wc = w & 1, fr = lane & 15, fq = lane >> 4;
    const int ns = pn * 128 + wc * 64;
#pragma unroll
    for (int mi = 0; mi < 4; ++mi) {
        const int t = pm * 128 + wr * 64 + mi * 16 + fr; float ss = 0.f;
#pragma unroll
        for (int ni = 0; ni < 4; ++ni) { const int n = ns + ni * 16 + 4 * fq; const size_t o = (size_t)t * D_ + n;
            const f32x4 v = acc[ni][mi] + *(const f32x4*)(P.x + o); const f32x4 g = *(const f32x4*)(P.g_ffn + n);
            ss += v[0] * v[0] + v[1] * v[1] + v[2] * v[2] + v[3] * v[3];
            *(f32x4*)(wsp<float>(P, O_H) + o) = v; *(u32x2*)(wsp<bf16_t>(P, O_HG) + o) = pack4(v * g); }
        ss = quad_sum(ss);
        if (fq == 0) wsp<float>(P, O_SSQH)[(size_t)t * 16 + (ns >> 6)] = ss;
    }
}
__device__ void p8_tile(const Params& P, int pm, int pn, unsigned char* smem, int tid) {
    f32x4 accg[4][4], accp[4][4]; zero_acc(accg); zero_acc(accp);
    gemm_acc(wsp<bf16_t>(P, O_HG) + (size_t)pm * 128 * D_, D_, wsp<bf16_t>(P, O_WPG) + (size_t)pn * 128 * D_, D_, D_, smem, accg, tid);
    gemm_acc(wsp<bf16_t>(P, O_PB) + (size_t)pm * 128 * 256, 256, wsp<bf16_t>(P, O_WPP) + (size_t)pn * 128 * 256, 256, 256, smem, accp, tid);
    const int lane = tid & 63, w = tid >> 6, wr = w >> 1, wc = w & 1, fr = lane & 15, fq = lane >> 4;
    const int ns = pn * 128 + wc * 64;
#pragma unroll
    for (int mi = 0; mi < 4; ++mi) {
        const int t = pm * 128 + wr * 64 + mi * 16 + fr; const float rs = wsp<float>(P, O_RSTD2)[t]; float ss = 0.f;
#pragma unroll
        for (int ni = 0; ni < 4; ++ni) { const int n = ns + ni * 16 + 4 * fq; const size_t o = (size_t)t * D_ + n;
            f32x4 v = *(const f32x4*)(wsp<float>(P, O_H) + o);
#pragma unroll
            for (int r = 0; r < 4; ++r) { v[r] += accp[ni][mi][r] / (1.0f + __expf(-rs * accg[ni][mi][r])); ss += v[r] * v[r]; }
            *(f32x4*)(P.out + o) = v; }
        ss = quad_sum(ss);
        if (fq == 0) wsp<float>(P, O_SSQ3)[(size_t)t * 16 + (ns >> 6)] = ss;
    }
}

template <int DQK, int NQB, bool BAND>
__device__ void attn_item(const bf16_t* __restrict__ Qb, int qrs, const bf16_t* __restrict__ Kb, int krs, const bf16_t* __restrict__ Vb,
                          int q0, int kt_begin, int kt_end, unsigned char* smem, int tid,
                          bf16_t* __restrict__ Ob, int ors, float* __restrict__ statb, int srs) {
    constexpr int KS = DQK / 32, KP = DQK * 2 + 16, CPR = DQK / 8, KCH = 64 * CPR / 256, VP = 144;
    const int lane = tid & 63, w = tid >> 6, fr = lane & 15, fq = lane >> 4;
    unsigned char* Ks = smem; unsigned char* Vs = smem + 64 * KP;
    bf16x8 qf[NQB][KS];
#pragma unroll
    for (int qb = 0; qb < NQB; ++qb)
#pragma unroll
        for (int ks = 0; ks < KS; ++ks) qf[qb][ks] = *(const bf16x8*)(Qb + (size_t)(q0 + 16 * (w * NQB + qb) + fr) * qrs + ks * 32 + fq * 8);
    f32x4 oacc[4][NQB]; float mrun[NQB], lrun[NQB];
#pragma unroll
    for (int qb = 0; qb < NQB; ++qb) { mrun[qb] = -1e30f; lrun[qb] = 0.f;
#pragma unroll
        for (int df = 0; df < 4; ++df) oacc[df][qb] = (f32x4){0.f, 0.f, 0.f, 0.f}; }
    u32x4 rk[KCH], rv[2];
    auto gload = [&](int kt) {
#pragma unroll
        for (int i = 0; i < KCH; ++i) { const int c = tid + 256 * i, row = c / CPR, ch = c % CPR; rk[i] = *(const u32x4*)(Kb + (size_t)(kt + row) * krs + ch * 8); }
#pragma unroll
        for (int i = 0; i < 2; ++i) { const int c = tid + 256 * i, d = c >> 3, ch = c & 7; rv[i] = *(const u32x4*)(Vb + (size_t)d * S_ + kt + ch * 8); }
    };
    auto sstore = [&]() {
#pragma unroll
        for (int i = 0; i < KCH; ++i) { const int c = tid + 256 * i, row = c / CPR, ch = c % CPR; *(u32x4*)(Ks + row * KP + ch * 16) = rk[i]; }
#pragma unroll
        for (int i = 0; i < 2; ++i) { const int c = tid + 256 * i, d = c >> 3, ch = c & 7; *(u32x4*)(Vs + d * VP + ch * 16) = rv[i]; }
    };
    gload(kt_begin); sstore(); __syncthreads();
    for (int kt = kt_begin; kt < kt_end; kt += 64) {
        const bool more = kt + 64 < kt_end;
        if (more) gload(kt + 64);
        f32x4 sacc[4][NQB];
#pragma unroll
        for (int kf = 0; kf < 4; ++kf) {
#pragma unroll
            for (int qb = 0; qb < NQB; ++qb) sacc[kf][qb] = (f32x4){0.f, 0.f, 0.f, 0.f};
#pragma unroll
            for (int ks = 0; ks < KS; ++ks) { const bf16x8 kfr = *(const bf16x8*)(Ks + (16 * kf + fr) * KP + ks * 64 + fq * 16);
#pragma unroll
                for (int qb = 0; qb < NQB; ++qb) sacc[kf][qb] = MFMA16(kfr, qf[qb][ks], sacc[kf][qb]); }
        }
        bf16x8 pf[NQB][2];
#pragma unroll
        for (int qb = 0; qb < NQB; ++qb) {
            if (BAND) { const int qpos = q0 + 16 * (w * NQB + qb) + fr;
#pragma unroll
                for (int kf = 0; kf < 4; ++kf)
#pragma unroll
                    for (int r = 0; r < 4; ++r) { const int dlt = qpos - (kt + 16 * kf + 4 * fq + r); if (dlt > 64 || dlt < -64) sacc[kf][qb][r] = -1e30f; } }
            float mx = -1e30f;
#pragma unroll
            for (int kf = 0; kf < 4; ++kf) mx = fmaxf(mx, fmaxf(fmaxf(sacc[kf][qb][0], sacc[kf][qb][1]), fmaxf(sacc[kf][qb][2], sacc[kf][qb][3])));
            mx = fmaxf(mx, __shfl_xor(mx, 16)); mx = fmaxf(mx, __shfl_xor(mx, 32));
            const float mn = fmaxf(mrun[qb], mx), alpha = exp2f(mrun[qb] - mn); mrun[qb] = mn;
            float ps = 0.f; unsigned pw[4][2];
#pragma unroll
            for (int kf = 0; kf < 4; ++kf) { const float p0 = exp2f(sacc[kf][qb][0] - mn), p1 = exp2f(sacc[kf][qb][1] - mn), p2 = exp2f(sacc[kf][qb][2] - mn), p3 = exp2f(sacc[kf][qb][3] - mn);
                ps += (p0 + p1) + (p2 + p3); pw[kf][0] = pack2(p0, p1); pw[kf][1] = pack2(p2, p3); }
            lrun[qb] = lrun[qb] * alpha + ps;
#pragma unroll
            for (int df = 0; df < 4; ++df) oacc[df][qb] = oacc[df][qb] * alpha;
#pragma unroll
            for (int c = 0; c < 2; ++c) { const u32x4 t4 = (u32x4){pw[2 * c][0], pw[2 * c][1], pw[2 * c + 1][0], pw[2 * c + 1][1]}; pf[qb][c] = *(const bf16x8*)&t4; }
        }
#pragma unroll
        for (int c = 0; c < 2; ++c)
#pragma unroll
            for (int df = 0; df < 4; ++df) {
                const unsigned char* vp = Vs + (16 * df + fr) * VP + (32 * c + 4 * fq) * 2;
                const u32x2 lo = *(const u32x2*)vp, hi = *(const u32x2*)(vp + 32);
                const u32x4 t4 = (u32x4){lo[0], lo[1], hi[0], hi[1]}; const bf16x8 vfr = *(const bf16x8*)&t4;
#pragma unroll
                for (int qb = 0; qb < NQB; ++qb) oacc[df][qb] = MFMA16(vfr, pf[qb][c], oacc[df][qb]);
            }
        __syncthreads();
        if (more) { sstore(); __syncthreads(); }
    }
#pragma unroll
    for (int qb = 0; qb < NQB; ++qb) {
        const float l = quad_sum(lrun[qb]), il = 1.0f / l; const int qi = q0 + 16 * (w * NQB + qb) + fr; float ss = 0.f;
#pragma unroll
        for (int df = 0; df < 4; ++df) { const f32x4 v = oacc[df][qb] * il; ss += v[0] * v[0] + v[1] * v[1] + v[2] * v[2] + v[3] * v[3]; *(u32x2*)(Ob + (size_t)qi * ors + 16 * df + 4 * fq) = pack4(v); }
        if (BAND) { if (fq == 0) statb[(size_t)qi * srs] = mrun[qb] + log2f(l); }
        else { ss = quad_sum(ss); if (fq == 0) statb[(size_t)qi * srs] = ss; }
    }
}
constexpr int N_MLA_ITEMS = 64 * 16, N_DIL_ITEMS = 3 * 64 * 32, N_ATT_ITEMS = N_MLA_ITEMS + N_DIL_ITEMS;
__device__ void attn_dispatch(const Params& P, int item, unsigned char* smem, int tid) {
    bf16_t* omla = (bf16_t*)P.out; bf16_t* opart = (bf16_t*)P.out + (size_t)T_ * 512;
    if (item < N_MLA_ITEMS) {
        const int bh = item >> 4, qt = item & 15, b = bh >> 3, h = bh & 7;
        attn_item<96, 2, false>(wsp<bf16_t>(P, O_QM) + (size_t)bh * S_ * 96, 96, wsp<bf16_t>(P, O_KM) + (size_t)bh * S_ * 96, 96, wsp<bf16_t>(P, O_VTM) + (size_t)bh * 64 * S_,
                                qt * 128, 0, S_, smem, tid, omla + (size_t)b * S_ * 512 + h * 64, 512, wsp<float>(P, O_SSMLA) + (size_t)b * S_ * 8 + h, 8);
    } else {
        const int it = item - N_MLA_ITEMS, p = it >> 11, rem = it & 2047, bh = rem >> 5, qt = rem & 31, b = bh >> 3, h = bh & 7;
        const int dil = dil_of(p), L = S_ / dil, tpr = L >> 6, res = qt / tpr, j0 = (qt - res * tpr) * 64;
        const int kb = j0 - 64 < 0 ? 0 : j0 - 64, ke = j0 + 128 > L ? L : j0 + 128;
        attn_item<64, 1, true>(wsp<bf16_t>(P, O_QD) + ((size_t)bh * S_ + res) * 64, dil * 64, wsp<bf16_t>(P, O_KD) + ((size_t)bh * S_ + res) * 64, dil * 64,
                               wsp<bf16_t>(P, O_VTD) + (size_t)p * T_ * 512 + (size_t)bh * 64 * S_ + res * L,
                               j0, kb, ke, smem, tid, opart + (size_t)p * T_ * 512 + ((size_t)b * S_ + res) * 512 + h * 64, dil * 512,
                               wsp<float>(P, O_LSE) + ((size_t)p * T_ + (size_t)b * S_ + res) * 8 + h, dil * 8);
    }
}

__device__ __forceinline__ unsigned f2key(float f) { const unsigned u = __float_as_uint(f); return (u & 0x80000000u) ? ~u : (u | 0x80000000u); }
__device__ __forceinline__ float key2f(unsigned k) { return __uint_as_float((k & 0x80000000u) ? (k ^ 0x80000000u) : ~k); }
__device__ __forceinline__ unsigned umax_(unsigned a, unsigned b) { return a > b ? a : b; }
__device__ __forceinline__ unsigned umin_(unsigned a, unsigned b) { return a < b ? a : b; }
__device__ __forceinline__ void ins16(unsigned (&L)[16], unsigned x) {
#pragma unroll
    for (int j = 0; j < 16; ++j) { const unsigned hi = umax_(L[j], x); x = umin_(L[j], x); L[j] = hi; }
}
__device__ __forceinline__ void bitonic_desc16(unsigned (&c)[16]) {
#pragma unroll
    for (int st = 8; st >= 1; st >>= 1)
#pragma unroll
        for (int j = 0; j < 16; ++j) if ((j & st) == 0) { const unsigned hi = umax_(c[j], c[j + st]), lo = umin_(c[j], c[j + st]); c[j] = hi; c[j + st] = lo; }
}
__device__ void p6_tile(const Params& P, int pm, int h, unsigned char* smem, int tid) {
    const int lane = tid & 63, w = tid >> 6, wr = w >> 1, wc = w & 1, fr = lane & 15, fq = lane >> 4;
    f32x4 sacc[2][4][4];
    {
        f32x4 acc[4][4]; zero_acc(acc);
        gemm_acc(wsp<bf16_t>(P, O_HG) + (size_t)pm * 128 * D_, D_, wsp<bf16_t>(P, O_WPQ) + (size_t)h * 128 * D_, D_, D_, smem, acc, tid);
#pragma unroll
        for (int mi = 0; mi < 4; ++mi) { const int row = wr * 64 + mi * 16 + fr; const int t = pm * 128 + row;
            const float rs = rstd_from(wsp<float>(P, O_SSQH) + (size_t)t * 16, 16, 1.0f / 1024.0f);
#pragma unroll
            for (int ni = 0; ni < 4; ++ni) *(u32x2*)(smem + row * 272 + (wc * 64 + ni * 16 + 4 * fq) * 2) = pack4(acc[ni][mi] * rs); }
    }
    __syncthreads();
#pragma unroll
    for (int half = 0; half < 2; ++half) {
        const bf16_t* kb = wsp<bf16_t>(P, half ? O_K2B : O_K1B);
#pragma unroll
        for (int ni = 0; ni < 4; ++ni)
#pragma unroll
            for (int mi = 0; mi < 4; ++mi) sacc[half][ni][mi] = (f32x4){0.f, 0.f, 0.f, 0.f};
#pragma unroll
        for (int ks = 0; ks < 2; ++ks) {
            bf16x8 kf[4], qfr[4];
#pragma unroll
            for (int i = 0; i < 4; ++i) { kf[i] = *(const bf16x8*)(kb + (wc * 64 + i * 16 + fr) * 64 + ks * 32 + fq * 8);
                qfr[i] = *(const bf16x8*)(smem + (wr * 64 + i * 16 + fr) * 272 + (half * 64 + ks * 32 + fq * 8) * 2); }
#pragma unroll
            for (int ni = 0; ni < 4; ++ni)
#pragma unroll
                for (int mi = 0; mi < 4; ++mi) sacc[half][ni][mi] = MFMA16(kf[ni], qfr[mi], sacc[half][ni][mi]);
        }
    }
    __syncthreads();
    unsigned* sk = (unsigned*)smem; const int row = tid >> 1, part = tid & 1;
    unsigned A[2][16];
#pragma unroll
    for (int half = 0; half < 2; ++half) {
#pragma unroll
        for (int mi = 0; mi < 4; ++mi)
#pragma unroll
            for (int ni = 0; ni < 4; ++ni)
#pragma unroll
                for (int r = 0; r < 4; ++r) { const int rw = wr * 64 + mi * 16 + fr, key = wc * 64 + ni * 16 + 4 * fq + r;
                    sk[rw * 128 + (key ^ fr)] = (f2key(sacc[half][ni][mi][r]) & ~127u) | (unsigned)key; }
        __syncthreads();
        unsigned L[16];
#pragma unroll
        for (int j = 0; j < 16; ++j) L[j] = 0u;
        for (int k = 0; k < 64; ++k) { const int key = (k & 15) | (part << 4) | ((k >> 4) << 5); ins16(L, sk[row * 128 + (key ^ (row & 15))]); }
        unsigned c[16];
#pragma unroll
        for (int j = 0; j < 16; ++j) c[j] = umax_(L[j], (unsigned)__shfl_xor((int)L[15 - j], 1));
        bitonic_desc16(c);
#pragma unroll
        for (int j = 0; j < 16; ++j) A[half][j] = c[j];
        __syncthreads();
    }
    unsigned C[16];
#pragma unroll
    for (int j = 0; j < 16; ++j) C[j] = 0u;
    float fa[16], fb[16];
#pragma unroll
    for (int j = 0; j < 16; ++j) { fa[j] = key2f(A[0][j] & ~127u); fb[j] = key2f(A[1][j] & ~127u); }
#pragma unroll
    for (int i = 0; i < 16; ++i)
#pragma unroll
        for (int j = 0; j < 16; ++j) if ((i + 1) * (j + 1) <= 16) ins16(C, (f2key(fa[i] + fb[j]) & ~255u) | (unsigned)(i * 16 + j));
    if (part == 0) {
        const int t = pm * 128 + row; float ev[16]; float den = 0.f; const float top0 = key2f(C[0] & ~255u); unsigned eo[16];
#pragma unroll
        for (int k = 0; k < 16; ++k) { const unsigned pos = C[k] & 255u, pi = pos >> 4, pj = pos & 15u; unsigned ia = 0u, ib = 0u;
#pragma unroll
            for (int j = 0; j < 16; ++j) { ia = (pi == (unsigned)j) ? (A[0][j] & 127u) : ia; ib = (pj == (unsigned)j) ? (A[1][j] & 127u) : ib; }
            eo[k] = ia * 128u + ib; ev[k] = __expf(key2f(C[k] & ~255u) - top0); den += ev[k]; }
        const float id = 1.0f / den;
        unsigned short* ep = wsp<unsigned short>(P, O_EIDX) + (size_t)t * 128 + h * 16; float* gp = wsp<float>(P, O_GATE) + (size_t)t * 128 + h * 16;
        *(u32x4*)ep = (u32x4){eo[0] | (eo[1] << 16), eo[2] | (eo[3] << 16), eo[4] | (eo[5] << 16), eo[6] | (eo[7] << 16)};
        *(u32x4*)(ep + 8) = (u32x4){eo[8] | (eo[9] << 16), eo[10] | (eo[11] << 16), eo[12] | (eo[13] << 16), eo[14] | (eo[15] << 16)};
#pragma unroll
        for (int k = 0; k < 4; ++k) *(f32x4*)(gp + 4 * k) = (f32x4){ev[4 * k] * id, ev[4 * k + 1] * id, ev[4 * k + 2] * id, ev[4 * k + 3] * id};
    }
}
__device__ __forceinline__ float dot16(const float (&x)[16], u32x4 a, u32x4 b) {
    float s = 0.f;
#pragma unroll
    for (int j = 0; j < 4; ++j) { s += x[2 * j] * bflo(a[j]); s += x[2 * j + 1] * bfhi(a[j]); s += x[8 + 2 * j] * bflo(b[j]); s += x[8 + 2 * j + 1] * bfhi(b[j]); }
    return s;
}
__device__ void p7_token(const Params& P, int t, int lane) {
    const bf16_t* hgr = wsp<bf16_t>(P, O_HG) + (size_t)t * D_;
    const u32x4 x0 = *(const u32x4*)(hgr + lane * 8), x1 = *(const u32x4*)(hgr + 512 + lane * 8);
    float xf[16], y[16];
#pragma unroll
    for (int j = 0; j < 4; ++j) { xf[2 * j] = bflo(x0[j]); xf[2 * j + 1] = bfhi(x0[j]); xf[8 + 2 * j] = bflo(x1[j]); xf[8 + 2 * j + 1] = bfhi(x1[j]); }
#pragma unroll
    for (int j = 0; j < 16; ++j) y[j] = 0.f;
    const float rs = rstd_from(wsp<float>(P, O_SSQH) + (size_t)t * 16, 16, 1.0f / 1024.0f);
    const unsigned evw = ((const unsigned*)(wsp<unsigned short>(P, O_EIDX) + (size_t)t * 128))[lane];
    const float g0 = wsp<float>(P, O_GATE)[(size_t)t * 128 + 2 * lane], g1 = wsp<float>(P, O_GATE)[(size_t)t * 128 + 2 * lane + 1];
    const bf16_t* UB = wsp<bf16_t>(P, O_UB); const bf16_t* VB = wsp<bf16_t>(P, O_VB);
    for (int g8 = 0; g8 < 16; ++g8) {
        unsigned e[8]; u32x4 ua[8], ub[8], va[8], vb[8]; float part[8];
#pragma unroll
        for (int j = 0; j < 8; ++j) { const unsigned wv = (unsigned)__builtin_amdgcn_readlane((int)evw, g8 * 4 + (j >> 1)); e[j] = (j & 1) ? (wv >> 16) : (wv & 0xffffu);
            const bf16_t* ur = UB + (size_t)e[j] * D_; ua[j] = *(const u32x4*)(ur + lane * 8); ub[j] = *(const u32x4*)(ur + 512 + lane * 8); }
#pragma unroll
        for (int j = 0; j < 8; ++j) { const bf16_t* vr = VB + (size_t)e[j] * D_; va[j] = *(const u32x4*)(vr + lane * 8); vb[j] = *(const u32x4*)(vr + 512 + lane * 8); }
#pragma unroll
        for (int j = 0; j < 8; ++j) part[j] = wave_sum(dot16(xf, ua[j], ub[j]));
#pragma unroll
        for (int j = 0; j < 8; ++j) {
            const float gj = __int_as_float(__builtin_amdgcn_readlane((j & 1) ? __float_as_int(g1) : __float_as_int(g0), g8 * 4 + (j >> 1)));
            const float a = rs * part[j]; const float cf = gj * 0.5f * a * (1.0f + erff(a * 0.70710678118654752f));
#pragma unroll
            for (int q = 0; q < 4; ++q) { y[2 * q] += cf * bflo(va[j][q]); y[2 * q + 1] += cf * bfhi(va[j][q]); y[8 + 2 * q] += cf * bflo(vb[j][q]); y[8 + 2 * q + 1] += cf * bfhi(vb[j][q]); }
        }
    }
    float* hr = wsp<float>(P, O_H) + (size_t)t * D_;
    f32x4 h0 = *(const f32x4*)(hr + lane * 8), h1 = *(const f32x4*)(hr + lane * 8 + 4), h2 = *(const f32x4*)(hr + 512 + lane * 8), h3 = *(const f32x4*)(hr + 512 + lane * 8 + 4);
    float ss = 0.f;
#pragma unroll
    for (int q = 0; q < 4; ++q) { h0[q] += y[q]; h1[q] += y[4 + q]; h2[q] += y[8 + q]; h3[q] += y[12 + q]; ss += h0[q] * h0[q] + h1[q] * h1[q] + h2[q] * h2[q] + h3[q] * h3[q]; }
    ss = wave_sum(ss);
    *(f32x4*)(hr + lane * 8) = h0; *(f32x4*)(hr + lane * 8 + 4) = h1; *(f32x4*)(hr + 512 + lane * 8) = h2; *(f32x4*)(hr + 512 + lane * 8 + 4) = h3;
    const f32x4 ga = *(const f32x4*)(P.g_ple + lane * 8), gb = *(const f32x4*)(P.g_ple + lane * 8 + 4), gc = *(const f32x4*)(P.g_ple + 512 + lane * 8), gd = *(const f32x4*)(P.g_ple + 512 + lane * 8 + 4);
    bf16_t* hgw = wsp<bf16_t>(P, O_HG) + (size_t)t * D_;
    const u32x2 wa = pack4(h0 * ga), wb = pack4(h1 * gb), wc2 = pack4(h2 * gc), wd = pack4(h3 * gd);
    *(u32x4*)(hgw + lane * 8) = (u32x4){wa[0], wa[1], wb[0], wb[1]}; *(u32x4*)(hgw + 512 + lane * 8) = (u32x4){wc2[0], wc2[1], wd[0], wd[1]};
    if (lane == 0) wsp<float>(P, O_RSTD2)[t] = rsqrtf(ss * (1.0f / D_) + EPS_);
}

__global__ void __launch_bounds__(256, 2) k_p1(Params P) { __shared__ __attribute__((aligned(16))) unsigned char smem[SMEM_BYTES];
    for (int i = blockIdx.x; i < 128 * 18; i += gridDim.x) p1_tile(P, i / 18, i % 18, smem, threadIdx.x); }
__global__ void __launch_bounds__(256, 2) k_p2(Params P) { __shared__ __attribute__((aligned(16))) unsigned char smem[SMEM_BYTES];
    for (int i = blockIdx.x; i < 128 * 14; i += gridDim.x) { const int pm = i / 14, j = i % 14; if (j < 6) p2a_tile(P, pm, j, smem, threadIdx.x); else p2b_tile(P, pm, j - 6, smem, threadIdx.x); } }
__global__ void __launch_bounds__(256, 2) k_p3(Params P) { __shared__ __attribute__((aligned(16))) unsigned char smem[SMEM_BYTES];
    for (int i = blockIdx.x; i < N_ATT_ITEMS; i += gridDim.x) { attn_dispatch(P, i, smem, threadIdx.x); __syncthreads(); } }
__global__ void __launch_bounds__(256, 2) k_p5(Params P) { __shared__ __attribute__((aligned(16))) unsigned char smem[SMEM_BYTES];
    for (int i = blockIdx.x; i < 128 * 8; i += gridDim.x) p5_tile(P, i >> 3, i & 7, smem, threadIdx.x); }
__global__ void __launch_bounds__(256, 2) k_p6(Params P) { __shared__ __attribute__((aligned(16))) unsigned char smem[SMEM_BYTES];
    for (int i = blockIdx.x; i < 128 * 8; i += gridDim.x) { p6_tile(P, i >> 3, i & 7, smem, threadIdx.x); __syncthreads(); } }
__global__ void __launch_bounds__(256, 2) k_p7(Params P) { const int lane = threadIdx.x & 63;
    for (int t = blockIdx.x * 4 + (threadIdx.x >> 6); t < T_; t += gridDim.x * 4) p7_token(P, t, lane); }
__global__ void __launch_bounds__(256, 2) k_p8(Params P) { __shared__ __attribute__((aligned(16))) unsigned char smem[SMEM_BYTES];
    for (int i = blockIdx.x; i < 128 * 8; i += gridDim.x) p8_tile(P, i >> 3, i & 7, smem, threadIdx.x); }

__global__ void __launch_bounds__(256) n_copy_h(Params P) { const long idx = (long)blockIdx.x * 256 + threadIdx.x; if (idx < (long)T_ * 1024) P.out[idx] = wsp<float>(P, O_H)[idx]; }
static inline int nblk(long n) { return (int)((n + 255) / 256); }

extern "C" void kernel_launch(void* const* d_in, const int* in_sizes, int n_in, void* d_out, int out_size, void* d_ws, size_t ws_size, hipStream_t stream) {
    if (ws_size < WS_NEED) { fprintf(stderr, "workspace too small: %zu < %zu\n", ws_size, (size_t)WS_NEED); return; }
    Params P{};
    const float** f = (const float**)&P;
    for (int i = 0; i < 21; ++i) f[i] = (const float*)d_in[i];
    P.out = (float*)d_out; P.ws = (unsigned char*)d_ws;

    k_prep<<<2048, 256, 0, stream>>>(P);
    k_p1<<<128 * 18, 256, 0, stream>>>(P);
    k_p2<<<128 * 14, 256, 0, stream>>>(P);
    k_p3<<<N_ATT_ITEMS, 256, 0, stream>>>(P);
    k_merge<<<1024, 256, 0, stream>>>(P);
    k_p5<<<1024, 256, 0, stream>>>(P);
    k_prep_tables<<<2048, 256, 0, stream>>>(P);
    k_p6<<<1024, 256, 0, stream>>>(P);
    k_p7<<<2048, 256, 0, stream>>>(P);
    k_p8<<<1024, 256, 0, stream>>>(P);
    k_final<<<1024, 256, 0, stream>>>(P);
}
```

```cpp
#include <hip/hip_runtime.h>
#include <stdint.h>
#include <cstdio>
#ifndef PHMASK
#define PHMASK 0xFFFF
#endif
#define PH(n) ((PHMASK >> (n)) & 1)
#define REP_P0 1
#define REP_P1 1
#define REP_P2 1
#define REP_P3 1
#define REP_P4 1
#define REP_P5 1
#define REP_P6 1
#define REP_P7 1
#define REP_P8 1
#ifndef ATT_THR
#define ATT_PMAX 256.0f
#endif

typedef unsigned short bf16_t;
typedef short bf16x8 __attribute__((ext_vector_type(8)));
typedef float f32x4 __attribute__((ext_vector_type(4)));
typedef unsigned u32x4 __attribute__((ext_vector_type(4)));
typedef unsigned u32x2 __attribute__((ext_vector_type(2)));
#define LAS __attribute__((address_space(3)))

constexpr int T_ = 16384, S_ = 2048, NB_ = 8, D_ = 1024;
constexpr int NIN = 2304;
constexpr int C_QD = 0, C_KD = 512, C_VD = 1024, C_CQ = 1536, C_CKV = 1920, C_KR = 2176, C_END = 2208;
constexpr float EPS_ = 1e-6f;
constexpr float LOG2E = 1.4426950408889634f;
constexpr float QS_MLA = 0.10206207261596577f * LOG2E;
constexpr float QS_DIL = 0.125f * LOG2E;
constexpr int NTHR = 512, NWAVE = 8;
constexpr int LDS_RING = 131072, LDS_TOPK = 256 * 132 * 4, LDS_CTL = LDS_TOPK, LDS_BYTES = LDS_CTL + 64;

constexpr size_t MiB = 1ull << 20;
constexpr size_t O_BAR   = 0;
constexpr size_t O_WIN   = 1 * MiB;
constexpr size_t O_WUQ   = 6 * MiB;
constexpr size_t O_WUKV  = 7 * MiB;
constexpr size_t O_WOUT  = 8 * MiB;
constexpr size_t O_WPQ   = 10 * MiB;
constexpr size_t O_WPG   = 12 * MiB;
constexpr size_t O_WPP   = 14 * MiB;
constexpr size_t O_K1B   = 14 * MiB + 512 * 1024;
constexpr size_t O_K2B   = O_K1B + 16384;
constexpr size_t O_COSM  = 15 * MiB;
constexpr size_t O_SINM  = O_COSM + 131072;
constexpr size_t O_COSD  = O_SINM + 131072;
constexpr size_t O_SIND  = O_COSD + 65536;
constexpr size_t O_RSTDX = O_SIND + 65536;
constexpr size_t O_RSTDQ = O_RSTDX + 65536;
constexpr size_t O_RSTDKV= O_RSTDX + 131072;
constexpr size_t O_RSTDH = O_RSTDX + 196608;
constexpr size_t O_RSTD2 = O_RSTDX + 262144;
constexpr size_t O_DUMMY = 15 * MiB + 768 * 1024;
constexpr size_t O_SSQQ  = 16 * MiB;
constexpr size_t O_SSQKV = 16 * MiB + 768 * 1024;
constexpr size_t O_SSMLA = 17 * MiB + 256 * 1024;
constexpr size_t O_SSQ3  = 16 * MiB;
constexpr size_t O_LSE   = 18 * MiB;
constexpr size_t O_SSQ2  = 19 * MiB + 512 * 1024;
constexpr size_t O_SSQH  = 20 * MiB;
constexpr size_t O_US    = 22 * MiB;
constexpr size_t O_VS    = O_US + 65536;
constexpr size_t O_PB    = 23 * MiB;
constexpr size_t O_D     = 31 * MiB;
constexpr size_t O_XB    = O_D;
constexpr size_t O_MIXED = O_D;
constexpr size_t O_GT    = O_D;
constexpr size_t O_CQ    = O_D + 32 * MiB;
constexpr size_t O_CKV   = O_D + 44 * MiB;
constexpr size_t O_QD    = O_D + 52 * MiB;
constexpr size_t O_KD    = O_D + 68 * MiB;
constexpr size_t O_VD    = O_D + 84 * MiB;
constexpr size_t O_QM    = O_D + 132 * MiB;
constexpr size_t O_KM    = O_D + 156 * MiB;
constexpr size_t O_VM    = O_D + 180 * MiB;
constexpr size_t O_HG    = O_D + 52 * MiB;
constexpr size_t O_UQ    = O_D + 100 * MiB;
constexpr size_t O_XQ    = O_D + 116 * MiB;
constexpr size_t O_VQ    = O_D + 196 * MiB;
constexpr size_t O_EIDX  = O_D + 212 * MiB;
constexpr size_t O_GATE  = O_D + 216 * MiB;
constexpr size_t WS_NEED = 256 * MiB;

struct Params {
    const float *x, *p, *g_mix, *w_in, *g_cq, *w_uq, *g_ckv, *w_ukv, *g_out_mla, *g_out_dil, *w_out, *g_ffn, *w_peer_q,
        *keys1, *keys2, *peer_u, *peer_v, *g_ple, *w_ple_gate, *w_ple_proj, *g_final;
    float* out;
    unsigned char* ws;
};

__device__ __forceinline__ bf16_t f2bf(float f) { unsigned u = __float_as_uint(f); u += 0x7fffu + ((u >> 16) & 1u); return (bf16_t)(u >> 16); }
__device__ __forceinline__ float bf2f(bf16_t b) { return __uint_as_float(((unsigned)b) << 16); }
typedef __bf16 bf16x2_t __attribute__((ext_vector_type(2)));
typedef float f32x2_t __attribute__((ext_vector_type(2)));
__device__ __forceinline__ unsigned pack2(float a, float b) { const f32x2_t v = {a, b}; const bf16x2_t r = __builtin_convertvector(v, bf16x2_t); return __builtin_bit_cast(unsigned, r); }
__device__ __forceinline__ float fexp2(float x) { return __builtin_amdgcn_exp2f(x); }
__device__ __forceinline__ float bflo(unsigned w) { return __uint_as_float(w << 16); }
__device__ __forceinline__ float bfhi(unsigned w) { return __uint_as_float(w & 0xffff0000u); }
#define DPP_I(v, ctrl) __builtin_amdgcn_update_dpp(0, (int)(v), (ctrl), 0xf, 0xf, true)
#define DPP_F(v, ctrl) __builtin_bit_cast(float, __builtin_amdgcn_update_dpp(0, __builtin_bit_cast(int, (float)(v)), (ctrl), 0xf, 0xf, true))
__device__ __forceinline__ float wave_sum(float v) {
    v += DPP_F(v, 0xB1); v += DPP_F(v, 0x4E); v += DPP_F(v, 0x141); v += DPP_F(v, 0x140);
    v += __shfl_xor(v, 16); v += __shfl_xor(v, 32);
    return v;
}
__device__ __forceinline__ float quad_sum(float v) { v += __shfl_xor(v, 16); v += __shfl_xor(v, 32); return v; }
__device__ __forceinline__ u32x2 pack4(f32x4 v) { return (u32x2){pack2(v[0], v[1]), pack2(v[2], v[3])}; }
template <typename Tp> __host__ __device__ __forceinline__ Tp* wsp(const Params& P, size_t off) { return (Tp*)(P.ws + off); }
__device__ __forceinline__ int dil_of(int p) { return p == 0 ? 1 : (p == 1 ? 4 : 16); }
__device__ __forceinline__ int respos(int s, int dil) { return (s % dil) * (S_ / dil) + s / dil; }
__device__ __forceinline__ float rstd_from(const float* part, int n, float invdim) { float s = 0.f; for (int i = 0; i < n; ++i) s += part[i]; return rsqrtf(s * invdim + EPS_); }
#define MFMA16(a, b, c) __builtin_amdgcn_mfma_f32_16x16x32_bf16((a), (b), (c), 0, 0, 0)

__device__ __forceinline__ int win_src_col(int n) {
    if (n < 512) return 672 + n;
    if (n < 1024) return 1184 + (n - 512);
    if (n < 1536) return 1696 + (n - 1024);
    if (n < 1920) return n - 1536;
    if (n < 2176) return 384 + (n - 1920);
    if (n < 2208) return 640 + (n - 2176);
    return -1;
}
__device__ __forceinline__ void wt_job(const float* __restrict__ W, int Nsrc, int K, int srccol, const float* __restrict__ g0, const float* __restrict__ g1, int gsplit,
                                       bf16_t* __restrict__ Wt, int n, int k0) {
    unsigned w[4];
#pragma unroll
    for (int j = 0; j < 4; ++j) {
        float a = 0.f, b = 0.f;
        if (srccol >= 0) {
            const int ka = k0 + 2 * j, kb = ka + 1;
            a = W[(size_t)ka * Nsrc + srccol]; b = W[(size_t)kb * Nsrc + srccol];
            if (g0) { a *= (ka < gsplit ? g0[ka] : g1[ka - gsplit]); b *= (kb < gsplit ? g0[kb] : g1[kb - gsplit]); }
        }
        w[j] = pack2(a, b);
    }
    *(u32x4*)(Wt + (size_t)n * K + k0) = (u32x4){w[0], w[1], w[2], w[3]};
}

__device__ __forceinline__ void prep_weights(const Params& P, long gtid, long gthreads) {
    for (long i = gtid; i < (long)NIN * 128; i += gthreads) { const int n = (int)(i % NIN), kc = (int)(i / NIN);
        wt_job(P.w_in, 2208, 1024, win_src_col(n), P.g_mix, P.g_mix, 1 << 30, wsp<bf16_t>(P, O_WIN), n, kc * 8); }
    for (long i = gtid; i < 2048L * 16; i += gthreads) { const int s = (int)(i >> 4), j = (int)(i & 15);
        const float inv = powf(500000.0f, -(float)(2 * j) / 32.0f); const float ang = (float)s * inv; float sn, cs; sincosf(ang, &sn, &cs);
        wsp<float>(P, O_COSM)[i] = cs; wsp<float>(P, O_SINM)[i] = sn; }
    for (long i = gtid; i < 2048L * 8; i += gthreads) { const int s = (int)(i >> 3), j = (int)(i & 7);
        const float inv = powf(500000.0f, -(float)(2 * j) / 16.0f); const float ang = (float)s * inv; float sn, cs; sincosf(ang, &sn, &cs);
        wsp<float>(P, O_COSD)[i] = cs; wsp<float>(P, O_SIND)[i] = sn; }
}
__device__ __forceinline__ void prep_weights_late(const Params& P, long gtid, long gthreads) {
    for (long i = gtid; i < 768L * 48; i += gthreads) { const int n = (int)(i % 768), kc = (int)(i / 768);
        wt_job(P.w_uq, 768, 384, n, P.g_cq, P.g_cq, 1 << 30, wsp<bf16_t>(P, O_WUQ), n, kc * 8); }
    for (long i = gtid; i < 1024L * 32; i += gthreads) { const int n = (int)(i % 1024), kc = (int)(i / 1024);
        wt_job(P.w_ukv, 1024, 256, n, P.g_ckv, P.g_ckv, 1 << 30, wsp<bf16_t>(P, O_WUKV), n, kc * 8); }
    for (long i = gtid; i < 1024L * 128; i += gthreads) { const int n = (int)(i % 1024), kc = (int)(i / 1024);
        wt_job(P.w_out, 1024, 1024, n, P.g_out_mla, P.g_out_dil, 512, wsp<bf16_t>(P, O_WOUT), n, kc * 8);
        wt_job(P.w_peer_q, 1024, 1024, n, P.g_ffn, P.g_ffn, 1 << 30, wsp<bf16_t>(P, O_WPQ), n, kc * 8);
        wt_job(P.w_ple_gate, 1024, 1024, n, P.g_ple, P.g_ple, 1 << 30, wsp<bf16_t>(P, O_WPG), n, kc * 8); }
    for (long i = gtid; i < 1024L * 32; i += gthreads) { const int n = (int)(i % 1024), kc = (int)(i / 1024);
        wt_job(P.w_ple_proj, 1024, 256, n, nullptr, nullptr, 0, wsp<bf16_t>(P, O_WPP), n, kc * 8); }
    for (long i = gtid; i < 128L * 64; i += gthreads) { wsp<bf16_t>(P, O_K1B)[i] = f2bf(P.keys1[i]); wsp<bf16_t>(P, O_K2B)[i] = f2bf(P.keys2[i]); }
}
__device__ __forceinline__ void prep_rows(const Params& P, long gwave, long gwaves, int lane, long tend = T_, long tstride = 0) {
    if (tstride == 0) tstride = gwaves;
    for (long t = gwave; t < tend; t += tstride) {
        const float* xr = P.x + (size_t)t * D_;
        float ss = 0.f; f32x4 v[4];
#pragma unroll
        for (int i = 0; i < 4; ++i) { v[i] = *(const f32x4*)(xr + i * 256 + lane * 4); ss += v[i][0] * v[i][0] + v[i][1] * v[i][1] + v[i][2] * v[i][2] + v[i][3] * v[i][3]; }
        ss = wave_sum(ss);
        bf16_t* xb = wsp<bf16_t>(P, O_XB) + (size_t)t * D_;
#pragma unroll
        for (int i = 0; i < 4; ++i) *(u32x2*)(xb + i * 256 + lane * 4) = (u32x2){pack2(v[i][0], v[i][1]), pack2(v[i][2], v[i][3])};
        if (lane == 0) wsp<float>(P, O_RSTDX)[t] = rsqrtf(ss * (1.0f / D_) + EPS_);
        const f32x4 pv = *(const f32x4*)(P.p + (size_t)t * 256 + lane * 4);
        *(u32x2*)(wsp<bf16_t>(P, O_PB) + (size_t)t * 256 + lane * 4) = (u32x2){pack2(pv[0], pv[1]), pack2(pv[2], pv[3])};
    }
}

#define XB_TMO      128
#define XB_XCNT(j)  (256  + 64 * (j))
#define XB_XSUB(j)  (1280 + 64 * (j))
#define XB_XGEN(j)  (2304 + 64 * (j))
#define XB_TOP      3328
#define XB_TOPGEN   3392
#define XCD_BAR_WORDS 3456
#define XB_SPIN_CAP (1u << 20)
#define LAS __attribute__((address_space(3)))
__device__ __forceinline__ unsigned xb_ld(unsigned* p)              { return __hip_atomic_load(p, __ATOMIC_RELAXED, __HIP_MEMORY_SCOPE_AGENT); }
__device__ __forceinline__ unsigned xb_add(unsigned* p, unsigned v) { return __hip_atomic_fetch_add(p, v, __ATOMIC_RELAXED, __HIP_MEMORY_SCOPE_AGENT); }
__device__ __forceinline__ unsigned xb_xcc_id() { return (unsigned)__builtin_amdgcn_s_getreg((3 << 11) | 20) & 0xFu; }
#define XB_SPIN(cond, bar) do { unsigned _sp = 0; while (cond) { __builtin_amdgcn_s_sleep(1); \
    if ((++_sp & 255u) == 0u) { if (xb_ld(&(bar)[XB_TMO])) break; if (_sp > XB_SPIN_CAP) { atomicAdd(&(bar)[XB_TMO], 1u); break; } } } } while (0)
struct XcdBarrier { unsigned* bar; unsigned x; volatile LAS unsigned* st; };
__device__ __forceinline__ XcdBarrier xcd_barrier_post(unsigned* bar, volatile LAS unsigned* st) {
    XcdBarrier b; b.bar = bar; b.x = xb_xcc_id(); b.st = st;
    if (threadIdx.x == 0) (void)xb_add(&bar[XB_XCNT(b.x)], 1u);
    return b;
}
__device__ __forceinline__ void xcd_barrier_complete(unsigned* bar, unsigned x, unsigned& nloc, unsigned& nx) {
    const unsigned G = gridDim.x * gridDim.y * gridDim.z;
    unsigned sum, cnt, mine, sp = 0u;
    for (;;) {
        sum = 0u; cnt = 0u; mine = 0u;
#pragma unroll
        for (unsigned j = 0; j < 16; ++j) { const unsigned c = xb_ld(&bar[XB_XCNT(j)]); sum += c; cnt += (c > 0u) ? 1u : 0u; mine = (j == x) ? c : mine; }
        if (sum == G) break;
        __builtin_amdgcn_s_sleep(1);
        if ((++sp & 255u) == 0u) { if (xb_ld(&bar[XB_TMO])) break; if (sp > XB_SPIN_CAP) { atomicAdd(&bar[XB_TMO], 1u); break; } }
    }
    nloc = mine > 0u ? mine : 1u; nx = cnt > 0u ? cnt : 1u;
}
__device__ __forceinline__ void xcd_barrier(const XcdBarrier& b, unsigned& epoch) {
    asm volatile("s_waitcnt vmcnt(0)" ::: "memory");
    __syncthreads();
    ++epoch;
    if (threadIdx.x == 0) {
        unsigned* bar = b.bar;
        __builtin_amdgcn_s_waitcnt(0);
        unsigned nloc = b.st[0], nx = b.st[1];
        if (nloc == 0u) { xcd_barrier_complete(bar, b.x, nloc, nx); b.st[0] = nloc; b.st[1] = nx; }
        const unsigned old = xb_add(&bar[XB_XSUB(b.x)], 1u);
        if (old + 1u == epoch * nloc) {
            __builtin_amdgcn_fence(__ATOMIC_RELEASE, "agent");
            asm volatile("s_waitcnt vmcnt(0)" ::: "memory");
            const unsigned og = xb_add(&bar[XB_TOP], 1u);
            if (og + 1u == epoch * nx) __hip_atomic_store(&bar[XB_TOPGEN], epoch, __ATOMIC_RELAXED, __HIP_MEMORY_SCOPE_AGENT);
        }
        XB_SPIN(xb_ld(&bar[XB_TOPGEN]) < epoch, bar);
        __builtin_amdgcn_fence(__ATOMIC_ACQUIRE, "agent");
        asm volatile("s_waitcnt vmcnt(0)" ::: "memory");
    }
    __syncthreads();
}

namespace pg8 {
#define PG8_LAS __attribute__((address_space(3)))
typedef unsigned short bf16_t;
typedef short bf16x8 __attribute__((ext_vector_type(8)));
typedef float f32x4 __attribute__((ext_vector_type(4)));
typedef unsigned u32x4 __attribute__((ext_vector_type(4)));
constexpr int BM = 256, BK = 64, HALF = 128, HTB = HALF * BK * 2  , STAGE_BYTES = 8 * HTB, NXCD = 8, WGM = 8;

__host__ __device__ __forceinline__ int lds_byte(int r, int c) { const int st = (r >> 4) * 2 + (c >> 5), rr = r & 15, cc = c & 31, ob = rr * 64 + cc * 2; return st * 1024 + (ob ^ (((ob >> 9) & 1) << 5)); }
__host__ __device__ __forceinline__ void stage_rc(int b, int& R, int& C) { const int st = b / 1024, sb = b % 1024, swz = sb ^ (((sb >> 9) & 1) << 5); R = (st >> 1) * 16 + swz / 64; C = (st & 1) * 32 + (swz % 64) / 2; }
__host__ __device__ __forceinline__ int perm32(int rho) { const int n = rho >> 4, i = rho & 15; return 8 * (i >> 2) + 4 * n + (i & 3); }

struct Unit { int pm, pn; };
struct Gemm { const bf16_t* A; const bf16_t* Bt; int M, N, K; };
template <class Epi, class Sched, bool ALIGN_EPI = false, bool SP2 = false>
__device__ __forceinline__ void gemm_phase(PG8_LAS unsigned char* lds, const Gemm g, const Sched& S, const Epi& E) {
    int tid_ = threadIdx.x; asm volatile("" : "+v"(tid_));
    const int tid = tid_, wid = __builtin_amdgcn_readfirstlane(tid >> 6), lane = tid & 63, wr = wid >> 2, wc = wid & 3, fr = lane & 15, fq = lane >> 4;
    const int K = g.K, nt = K / BK;
    unsigned voffA[2], voffB[2];
#pragma unroll
    for (int i = 0; i < 2; ++i) { int R, C; stage_rc(tid * 16 + i * 8192, R, C); const int Rb = Epi::PERM ? ((R & ~31) + perm32(R & 31)) : R;
        voffA[i] = (unsigned)(R * K + C) * 2u; voffB[i] = (unsigned)(Rb * K + C) * 2u; }
    const size_t kstep = (size_t)(BK * 2);
    const size_t hstep = (size_t)HALF * K * 2;
    const size_t tstep = 2 * hstep;
    const unsigned ldsw = (unsigned)wid * 1024u;
    const int aoff = lds_byte(wr * 64 + fr, fq * 8), boff = lds_byte(wc * 32 + fr, fq * 8);
#define PG8_SA(b, h) (((b) * 2 + (h)) * HTB)
#define PG8_SB(b, h) ((4 + (b) * 2 + (h)) * HTB)
#define PG8_STAGE(bufoff, gbase, voff) do { _Pragma("unroll") for (int _i = 0; _i < 2; ++_i) \
        __builtin_amdgcn_global_load_lds((const unsigned*)((const char*)(gbase) + (voff)[_i]), (PG8_LAS unsigned*)(lds + (bufoff) + ldsw + _i * 8192), 16, 0, 0); } while (0)
#define PG8_LDA(dst, b, h) do { _Pragma("unroll") for (int m = 0; m < 4; ++m) _Pragma("unroll") for (int k = 0; k < 2; ++k) dst[m][k] = *(const PG8_LAS bf16x8*)(lds + PG8_SA(b, h) + aoff + m * 2048 + k * 1024); } while (0)
#define PG8_LDB(dst, b, h) do { _Pragma("unroll") for (int n = 0; n < 2; ++n) _Pragma("unroll") for (int k = 0; k < 2; ++k) dst[n][k] = *(const PG8_LAS bf16x8*)(lds + PG8_SB(b, h) + boff + n * 2048 + k * 1024); } while (0)
#define PG8_MMA(ai, bj, At, Bt) do { __builtin_amdgcn_s_setprio(1); _Pragma("unroll") for (int m = 0; m < 4; ++m) _Pragma("unroll") for (int n = 0; n < 2; ++n) _Pragma("unroll") for (int k = 0; k < 2; ++k) \
        acc[ai][bj][m][n] = __builtin_amdgcn_mfma_f32_16x16x32_bf16(Bt[n][k], At[m][k], acc[ai][bj][m][n], 0, 0, 0); __builtin_amdgcn_s_setprio(0); } while (0)
#define PG8_WAIT_V(n) asm volatile("s_waitcnt vmcnt(" #n ")" ::: "memory")
#define PG8_WAIT_L(n) asm volatile("s_waitcnt lgkmcnt(" #n ")" ::: "memory")
#define PG8_BAR __builtin_amdgcn_s_barrier()
#define PG8_SCHED __builtin_amdgcn_sched_barrier(0)
    Unit cur, nxt; int ui = 0;
    if (!S.next(0, cur)) return;
    f32x4 acc[2][2][4][2];
#pragma unroll
    for (int a = 0; a < 2; ++a)
#pragma unroll
        for (int b = 0; b < 2; ++b)
#pragma unroll
            for (int m = 0; m < 4; ++m)
#pragma unroll
                for (int n = 0; n < 2; ++n) acc[a][b][m][n] = (f32x4){0.f, 0.f, 0.f, 0.f};
    bf16x8 At[4][2], B0[2][2], B1[2][2];
    const char* cA = (const char*)g.A + (size_t)cur.pm * tstep; const char* cB = (const char*)g.Bt + (size_t)cur.pn * tstep;
    S.a_ready(cur);
    if constexpr (SP2) {
        PG8_STAGE(PG8_SB(0, 0), cB, voffB); PG8_STAGE(PG8_SB(0, 1), cB + hstep, voffB); PG8_STAGE(PG8_SA(0, 0), cA, voffA); PG8_STAGE(PG8_SA(0, 1), cA + hstep, voffA);
        if (wr == 1) PG8_BAR;
        PG8_WAIT_V(2); PG8_BAR;
        PG8_STAGE(PG8_SB(1, 0), cB + kstep, voffB); PG8_STAGE(PG8_SA(1, 0), cA + kstep, voffA); PG8_STAGE(PG8_SB(1, 1), cB + hstep + kstep, voffB);
        PG8_WAIT_V(6); PG8_BAR;
    } else {
        PG8_STAGE(PG8_SB(0, 0), cB, voffB); PG8_STAGE(PG8_SA(0, 0), cA, voffA); PG8_STAGE(PG8_SB(0, 1), cB + hstep, voffB); PG8_STAGE(PG8_SA(0, 1), cA + hstep, voffA);
        if (wr == 1) PG8_BAR;
        PG8_WAIT_V(4); PG8_BAR;
        PG8_STAGE(PG8_SB(1, 0), cB + kstep, voffB); PG8_STAGE(PG8_SA(1, 0), cA + kstep, voffA); PG8_STAGE(PG8_SB(1, 1), cB + hstep + kstep, voffB);
        PG8_WAIT_V(6); PG8_BAR;
    }
    for (;;) {
        const bool has_next = S.next(ui + 1, nxt);
        const char* nA = has_next ? (const char*)g.A + (size_t)nxt.pm * tstep : cA; const char* nB = has_next ? (const char*)g.Bt + (size_t)nxt.pn * tstep : cB;
        for (int t = 0; t < nt; t += 2) {
            const bool last = (t == nt - 2);
            const char* a1 = cA + (size_t)(t + 1) * kstep;
            const char* a2 = last ? nA : cA + (size_t)(t + 2) * kstep; const char* b2 = last ? nB : cB + (size_t)(t + 2) * kstep;
            const char* a3 = a2 + kstep; const char* b3 = b2 + kstep;
            if (last && has_next) S.a_ready(nxt);
            if constexpr (SP2) {
            PG8_LDB(B0, 0, 0); PG8_LDB(B1, 0, 1); PG8_SCHED; PG8_LDA(At, 0, 0); PG8_STAGE(PG8_SA(1, 1), a1 + hstep, voffA);
            PG8_WAIT_V(8); PG8_WAIT_L(0); PG8_BAR; PG8_MMA(0, 0, At, B0); PG8_MMA(0, 1, At, B1); PG8_BAR; PG8_SCHED;
            PG8_LDA(At, 0, 1); PG8_STAGE(PG8_SB(0, 0), b2, voffB); PG8_STAGE(PG8_SB(0, 1), b2 + hstep, voffB); PG8_STAGE(PG8_SA(0, 0), a2, voffA);
            PG8_WAIT_V(8); PG8_WAIT_L(0); PG8_BAR; PG8_MMA(1, 0, At, B0); PG8_MMA(1, 1, At, B1); PG8_BAR; PG8_SCHED;
            PG8_LDB(B0, 1, 0); PG8_LDB(B1, 1, 1); PG8_SCHED; PG8_LDA(At, 1, 0); PG8_STAGE(PG8_SA(0, 1), a2 + hstep, voffA);
            PG8_WAIT_V(8); PG8_WAIT_L(0); PG8_BAR; PG8_MMA(0, 0, At, B0); PG8_MMA(0, 1, At, B1); PG8_BAR; PG8_SCHED;
            PG8_LDA(At, 1, 1); PG8_STAGE(PG8_SB(1, 0), b3, voffB); PG8_STAGE(PG8_SB(1, 1), b3 + hstep, voffB); PG8_STAGE(PG8_SA(1, 0), a3, voffA);
            PG8_WAIT_V(8); PG8_WAIT_L(0); PG8_BAR; PG8_MMA(1, 0, At, B0); PG8_MMA(1, 1, At, B1); PG8_BAR; PG8_SCHED;
            } else {
            PG8_LDB(B0, 0, 0); PG8_SCHED; PG8_LDA(At, 0, 0); PG8_STAGE(PG8_SA(1, 1), a1 + hstep, voffA);
            PG8_WAIT_L(8); PG8_BAR; PG8_WAIT_L(0); PG8_MMA(0, 0, At, B0); PG8_BAR; PG8_SCHED;
            PG8_LDB(B1, 0, 1); PG8_STAGE(PG8_SB(0, 0), b2, voffB);
            PG8_BAR; PG8_WAIT_L(0); PG8_MMA(0, 1, At, B1); PG8_BAR;
            PG8_LDA(At, 0, 1); PG8_STAGE(PG8_SA(0, 0), a2, voffA);
            PG8_BAR; PG8_WAIT_L(0); PG8_MMA(1, 0, At, B0); PG8_BAR; PG8_SCHED;
            PG8_STAGE(PG8_SB(0, 1), b2 + hstep, voffB);
            PG8_WAIT_V(6); PG8_BAR; PG8_MMA(1, 1, At, B1); PG8_BAR;
            PG8_LDB(B0, 1, 0); PG8_SCHED; PG8_LDA(At, 1, 0); PG8_STAGE(PG8_SA(0, 1), a2 + hstep, voffA);
            PG8_WAIT_L(8); PG8_BAR; PG8_WAIT_L(0); PG8_MMA(0, 0, At, B0); PG8_BAR; PG8_SCHED;
            PG8_LDB(B1, 1, 1); PG8_STAGE(PG8_SB(1, 0), b3, voffB);
            PG8_BAR; PG8_WAIT_L(0); PG8_MMA(0, 1, At, B1); PG8_BAR;
            PG8_LDA(At, 1, 1); PG8_STAGE(PG8_SA(1, 0), a3, voffA);
            PG8_BAR; PG8_WAIT_L(0); PG8_MMA(1, 0, At, B0); PG8_BAR; PG8_SCHED;
            PG8_STAGE(PG8_SB(1, 1), b3 + hstep, voffB);
            PG8_WAIT_V(6); PG8_BAR; PG8_MMA(1, 1, At, B1); PG8_BAR;
            }
        }
        if constexpr (ALIGN_EPI) { if (wr == 0) PG8_BAR; }
        if constexpr (!Epi::AFTER_DRAIN) { E(acc, cur, wr, wc, fr, fq); S.done(cur); }
        if (!has_next) break;
#pragma unroll
        for (int a = 0; a < 2; ++a)
#pragma unroll
            for (int b = 0; b < 2; ++b)
#pragma unroll
                for (int m = 0; m < 4; ++m)
#pragma unroll
                    for (int n = 0; n < 2; ++n) acc[a][b][m][n] = (f32x4){0.f, 0.f, 0.f, 0.f};
        cur = nxt; cA = nA; cB = nB; ++ui;
        if constexpr (ALIGN_EPI) { if (wr == 1) PG8_BAR; }
    }
    PG8_WAIT_V(0);
    if constexpr (!ALIGN_EPI) { if (wr == 0) PG8_BAR; }
    PG8_BAR;
    if constexpr (Epi::AFTER_DRAIN) { E.fused(acc, cur, wr, wc, fr, fq, lds, wid, lane); S.done(cur); }
#undef PG8_SA
#undef PG8_SB
#undef PG8_STAGE
#undef PG8_LDA
#undef PG8_LDB
#undef PG8_MMA
#undef PG8_WAIT_V
#undef PG8_WAIT_L
#undef PG8_BAR
#undef PG8_SCHED
}
}

__device__ __forceinline__ void rows_rstd(const float* part, int npart, float invdim, float* out, int pm, int t256) {
    const int t = pm * 256 + t256; float s = 0.f;
    for (int i = 0; i < npart; ++i) s += part[(size_t)t * npart + i];
    out[t] = rsqrtf(s * invdim + EPS_);
}
__device__ __forceinline__ int opaque(int v) { asm volatile("" : "+s"(v)); return v; }
__device__ __forceinline__ int opq_v(int v) { asm volatile("" : "+v"(v)); return v; }
#define WG_PUBLISH() do { asm volatile("s_waitcnt vmcnt(0)" ::: "memory"); __builtin_amdgcn_fence(__ATOMIC_RELEASE, "workgroup"); __syncthreads(); __builtin_amdgcn_fence(__ATOMIC_ACQUIRE, "workgroup"); } while (0)
struct XSched {
    int xg, lb, nlb, npn;
    __device__ __forceinline__ bool next(int i, pg8::Unit& u) const { const int j = lb + i * nlb; if (j >= 8 * npn) return false; u.pm = xg * 8 + (j & 7); u.pn = j >> 3; return true; }
    __device__ __forceinline__ void a_ready(const pg8::Unit&) const {}
    __device__ __forceinline__ void done(const pg8::Unit&) const {}
};
typedef f32x4 Acc8[2][2][4][2];

struct Epi1 {
    static constexpr bool PERM = false, AFTER_DRAIN = false; Params P;
    __device__ __forceinline__ void operator()(const Acc8& acc, const pg8::Unit& u, int wr, int wc, int fr, int fq) const {
#pragma unroll
        for (int bj = 0; bj < 2; ++bj) {
            const int cg = u.pn * 256 + bj * 128 + wc * 32;
            if (cg >= C_KR + 32) continue;
#pragma unroll
            for (int ai = 0; ai < 2; ++ai)
#pragma unroll
                for (int m = 0; m < 4; ++m) {
                    const int t = u.pm * 256 + ai * 128 + wr * 64 + m * 16 + fr, b = t >> 11, s = t & 2047;
                    const float rs = wsp<float>(P, O_RSTDX)[t];
                    if (cg < C_VD) {
                        const bool isq = cg < C_KD; const int cc = isq ? cg : cg - C_KD, h = cc >> 6, d0 = cc & 63;
                        bf16_t* dst = wsp<bf16_t>(P, isq ? O_QD : O_KD) + (((size_t)b * 8 + h) * S_ + s) * 64 + d0;
#pragma unroll
                        for (int n = 0; n < 2; ++n) {
                            f32x4 v = acc[ai][bj][m][n] * rs;
                            if (d0 == 0 && n == 0) {
#pragma unroll
                                for (int r = 0; r < 4; ++r) { const float pv = __shfl_xor(v[r], 32); const int j = (4 * fq + r) & 7;
                                    const float cs = wsp<float>(P, O_COSD)[s * 8 + j], sn = wsp<float>(P, O_SIND)[s * 8 + j];
                                    v[r] = fq < 2 ? v[r] * cs - pv * sn : v[r] * cs + pv * sn; }
                            }
                            if (isq) v = v * QS_DIL;
                            *(u32x2*)(dst + n * 16 + 4 * fq) = pack4(v);
                        }
                    } else if (cg < C_CQ) {
                        const int h = (cg - C_VD) >> 6, d0 = (cg - C_VD) & 63;
                        bf16_t* dst = wsp<bf16_t>(P, O_VD) + (((size_t)b * 8 + h) * S_ + s) * 64 + d0;
#pragma unroll
                        for (int n = 0; n < 2; ++n) *(u32x2*)(dst + n * 16 + 4 * fq) = pack4(acc[ai][bj][m][n] * rs);
                    } else if (cg < C_KR) {
                        const bool isq = cg < C_CKV; const int c0 = isq ? cg - C_CQ : cg - C_CKV;
                        bf16_t* dst = isq ? wsp<bf16_t>(P, O_CQ) + (size_t)t * 384 + c0 : wsp<bf16_t>(P, O_CKV) + (size_t)t * 256 + c0;
                        float ss = 0.f;
#pragma unroll
                        for (int n = 0; n < 2; ++n) { const f32x4 v = acc[ai][bj][m][n] * rs; ss += v[0] * v[0] + v[1] * v[1] + v[2] * v[2] + v[3] * v[3]; *(u32x2*)(dst + n * 16 + 4 * fq) = pack4(v); }
                        ss = quad_sum(ss);
                        if (fq == 0) { if (isq) wsp<float>(P, O_SSQQ)[(size_t)t * 12 + (c0 >> 5)] = ss; else wsp<float>(P, O_SSQKV)[(size_t)t * 8 + (c0 >> 5)] = ss; }
                    } else {
                        const f32x4 x1 = acc[ai][bj][m][0] * rs, x2 = acc[ai][bj][m][1] * rs; f32x4 o1, o2;
#pragma unroll
                        for (int r = 0; r < 4; ++r) { const int j = 4 * fq + r; const float cs = wsp<float>(P, O_COSM)[s * 16 + j], sn = wsp<float>(P, O_SINM)[s * 16 + j];
                            o1[r] = x1[r] * cs - x2[r] * sn; o2[r] = x2[r] * cs + x1[r] * sn; }
                        const u32x2 w1 = pack4(o1), w2 = pack4(o2);
#pragma unroll
                        for (int h = 0; h < 8; ++h) { bf16_t* dst = wsp<bf16_t>(P, O_KM) + (((size_t)b * 8 + h) * S_ + s) * 96 + 64 + 4 * fq; *(u32x2*)dst = w1; *(u32x2*)(dst + 16) = w2; }
                    }
                    asm volatile("" ::: "memory");
                }
        }
    }
};
struct Epi2a {
    static constexpr bool PERM = false, AFTER_DRAIN = false; Params P;
    __device__ __forceinline__ void operator()(const Acc8& acc, const pg8::Unit& u, int wr, int wc, int fr, int fq) const {
#pragma unroll
        for (int ai = 0; ai < 2; ++ai)
#pragma unroll
            for (int m = 0; m < 4; ++m) {
                const int t = u.pm * 256 + ai * 128 + wr * 64 + m * 16 + fr, b = t >> 11, s = t & 2047;
                const float rs = wsp<float>(P, O_RSTDQ)[t] * QS_MLA;
#pragma unroll
                for (int bj = 0; bj < 2; ++bj) {
                    const int cg = u.pn * 256 + bj * 128 + wc * 32, hq = cg / 96, d0 = cg - hq * 96;
                    bf16_t* dst = wsp<bf16_t>(P, O_QM) + (((size_t)b * 8 + hq) * S_ + s) * 96;
                    if (d0 < 64) {
#pragma unroll
                        for (int n = 0; n < 2; ++n) *(u32x2*)(dst + d0 + n * 16 + 4 * fq) = pack4(acc[ai][bj][m][n] * rs);
                    } else {
                        const f32x4 x1 = acc[ai][bj][m][0] * rs, x2 = acc[ai][bj][m][1] * rs; f32x4 o1, o2;
#pragma unroll
                        for (int r = 0; r < 4; ++r) { const int j = 4 * fq + r; const float cs = wsp<float>(P, O_COSM)[s * 16 + j], sn = wsp<float>(P, O_SINM)[s * 16 + j];
                            o1[r] = x1[r] * cs - x2[r] * sn; o2[r] = x2[r] * cs + x1[r] * sn; }
                        *(u32x2*)(dst + 64 + 4 * fq) = pack4(o1); *(u32x2*)(dst + 80 + 4 * fq) = pack4(o2);
                    }
                }
                asm volatile("" ::: "memory");
            }
    }
};
struct Epi2b {
    static constexpr bool PERM = false, AFTER_DRAIN = false; Params P;
    __device__ __forceinline__ void operator()(const Acc8& acc, const pg8::Unit& u, int wr, int wc, int fr, int fq) const {
#pragma unroll
        for (int ai = 0; ai < 2; ++ai)
#pragma unroll
            for (int m = 0; m < 4; ++m) {
                const int t = u.pm * 256 + ai * 128 + wr * 64 + m * 16 + fr, b = t >> 11, s = t & 2047;
                const float rs = wsp<float>(P, O_RSTDKV)[t];
#pragma unroll
                for (int bj = 0; bj < 2; ++bj) {
                    const int cg = u.pn * 256 + bj * 128 + wc * 32, h = cg >> 7, d0 = cg & 127;
#pragma unroll
                    for (int n = 0; n < 2; ++n) { const f32x4 v = acc[ai][bj][m][n] * rs;
                        if (d0 < 64) *(u32x2*)(wsp<bf16_t>(P, O_KM) + (((size_t)b * 8 + h) * S_ + s) * 96 + d0 + n * 16 + 4 * fq) = pack4(v);
                        else *(u32x2*)(wsp<bf16_t>(P, O_VM) + (((size_t)b * 8 + h) * S_ + s) * 64 + (d0 - 64) + n * 16 + 4 * fq) = pack4(v);
                    }
                }
            }
    }
};
struct Epi5 {
    static constexpr bool PERM = false, AFTER_DRAIN = false; Params P;
    __device__ __forceinline__ void operator()(const Acc8& acc, const pg8::Unit& u, int wr, int wc, int fr, int fq) const {
#pragma unroll
        for (int ai = 0; ai < 2; ++ai)
#pragma unroll
            for (int m = 0; m < 4; ++m) {
                const int t = u.pm * 256 + ai * 128 + wr * 64 + m * 16 + fr;
#pragma unroll
                for (int bj = 0; bj < 2; ++bj) { const int cg = u.pn * 256 + bj * 128 + wc * 32; float ss = 0.f;
#pragma unroll
                    for (int n = 0; n < 2; ++n) { const int c = cg + n * 16 + 4 * fq; const size_t o = (size_t)t * D_ + c;
                        const f32x4 v = acc[ai][bj][m][n] + *(const f32x4*)(P.x + o);
                        ss += v[0] * v[0] + v[1] * v[1] + v[2] * v[2] + v[3] * v[3];
                        *(u32x2*)(wsp<bf16_t>(P, O_HG) + o) = pack4(v); }
                    ss = quad_sum(ss);
                    if (fq == 0) wsp<float>(P, O_SSQH)[(size_t)t * 32 + (cg >> 5)] = ss; }
            }
    }
};
struct Epi8a {
    static constexpr bool PERM = false, AFTER_DRAIN = false; Params P;
    __device__ __forceinline__ void operator()(const Acc8& acc, const pg8::Unit& u, int wr, int wc, int fr, int fq) const {
#pragma unroll
        for (int ai = 0; ai < 2; ++ai)
#pragma unroll
            for (int m = 0; m < 4; ++m) {
                const int t = u.pm * 256 + ai * 128 + wr * 64 + m * 16 + fr;
                const float rs = wsp<float>(P, O_RSTD2)[t];
#pragma unroll
                for (int bj = 0; bj < 2; ++bj)
#pragma unroll
                    for (int n = 0; n < 2; ++n) { const int c = u.pn * 256 + bj * 128 + wc * 32 + n * 16 + 4 * fq; f32x4 g;
#pragma unroll
                        for (int r = 0; r < 4; ++r) g[r] = 1.0f / (1.0f + __expf(-rs * acc[ai][bj][m][n][r]));
                        *(u32x2*)(wsp<bf16_t>(P, O_GT) + (size_t)t * D_ + c) = pack4(g); }
            }
    }
};
constexpr int PANEL_CNT0 = 4096;
struct Epi8b {
    static constexpr bool PERM = false, AFTER_DRAIN = true; Params P;
    __device__ __forceinline__ void operator()(const Acc8&, const pg8::Unit&, int, int, int, int) const {}
    __device__ __forceinline__ void fused(Acc8& acc, const pg8::Unit& u, int wr, int wc, int fr, int fq, LAS unsigned char* lds, int wid, int lane) const {
        const int tid = wid * 64 + lane;
#pragma unroll
        for (int ai = 0; ai < 2; ++ai)
#pragma unroll
            for (int m = 0; m < 4; ++m) {
                const int t = u.pm * 256 + ai * 128 + wr * 64 + m * 16 + fr;
#pragma unroll
                for (int bj = 0; bj < 2; ++bj) { const int cg = u.pn * 256 + bj * 128 + wc * 32; float ss = 0.f;
#pragma unroll
                    for (int n = 0; n < 2; ++n) { const int c = cg + n * 16 + 4 * fq; const size_t o = (size_t)t * D_ + c;
                        const u32x2 hw = *(const u32x2*)(wsp<bf16_t>(P, O_HG) + o); f32x4 v = (f32x4){bflo(hw[0]), bfhi(hw[0]), bflo(hw[1]), bfhi(hw[1])}; const u32x2 gw = *(const u32x2*)(wsp<bf16_t>(P, O_GT) + o);
                        v[0] += bflo(gw[0]) * acc[ai][bj][m][n][0]; v[1] += bfhi(gw[0]) * acc[ai][bj][m][n][1]; v[2] += bflo(gw[1]) * acc[ai][bj][m][n][2]; v[3] += bfhi(gw[1]) * acc[ai][bj][m][n][3];
                        ss += v[0] * v[0] + v[1] * v[1] + v[2] * v[2] + v[3] * v[3];
                        acc[ai][bj][m][n] = v; }
                    ss = quad_sum(ss);
                    if (fq == 0) wsp<float>(P, O_SSQ3)[(size_t)t * 32 + (cg >> 5)] = ss; }
                asm volatile("" ::: "memory");
            }
        asm volatile("s_waitcnt vmcnt(0)" ::: "memory");
        __syncthreads();
        if (tid == 0) {
            unsigned* bar = (unsigned*)(P.ws + O_BAR); unsigned* cnt = bar + PANEL_CNT0 + 64 * u.pm;
            __builtin_amdgcn_fence(__ATOMIC_RELEASE, "agent");
            asm volatile("s_waitcnt vmcnt(0)" ::: "memory");
            (void)xb_add(cnt, 1u);
            XB_SPIN(xb_ld(cnt) < 4u, bar);
            __builtin_amdgcn_fence(__ATOMIC_ACQUIRE, "agent");
            asm volatile("s_waitcnt vmcnt(0)" ::: "memory");
        }
        __syncthreads();
        LAS float* rsl = (LAS float*)lds;
        if (tid < 256) { const int t = u.pm * 256 + tid; float sm = 0.f;
#pragma unroll
            for (int i = 0; i < 8; ++i) { const f32x4 pv = *(const f32x4*)(wsp<float>(P, O_SSQ3) + (size_t)t * 32 + 4 * i); sm += (pv[0] + pv[1]) + (pv[2] + pv[3]); }
            rsl[tid] = rsqrtf(sm * (1.0f / D_) + EPS_); }
        __syncthreads();
#pragma unroll
        for (int ai = 0; ai < 2; ++ai)
#pragma unroll
            for (int m = 0; m < 4; ++m) {
                const int row = ai * 128 + wr * 64 + m * 16 + fr; const float rs = rsl[row];
#pragma unroll
                for (int bj = 0; bj < 2; ++bj)
#pragma unroll
                    for (int n = 0; n < 2; ++n) { const int c = u.pn * 256 + bj * 128 + wc * 32 + n * 16 + 4 * fq; const f32x4 g = *(const f32x4*)(P.g_final + c);
                        f32x4 v = acc[ai][bj][m][n]; v[0] *= rs * g[0]; v[1] *= rs * g[1]; v[2] *= rs * g[2]; v[3] *= rs * g[3];
                        *(f32x4*)(P.out + (size_t)(u.pm * 256 + row) * D_ + c) = v; }
                asm volatile("" ::: "memory");
            }
    }
};
__device__ __forceinline__ unsigned f2key(float f) { const unsigned u = __float_as_uint(f); return u ^ ((unsigned)((int)u >> 31) | 0x80000000u); }
__device__ __forceinline__ float key2f(unsigned k) { return __uint_as_float(k ^ (~(unsigned)((int)k >> 31) | 0x80000000u)); }
__device__ __forceinline__ unsigned umax_(unsigned a, unsigned b) { return a > b ? a : b; }
__device__ __forceinline__ unsigned umin_(unsigned a, unsigned b) { return a < b ? a : b; }
__device__ __forceinline__ void ins16(unsigned (&L)[16], unsigned x) {
#pragma unroll
    for (int j = 0; j < 16; ++j) { const unsigned hi = umax_(L[j], x); x = umin_(L[j], x); L[j] = hi; }
}
__device__ __forceinline__ void bitonic_desc16(unsigned (&c)[16]) {
#pragma unroll
    for (int st = 8; st >= 1; st >>= 1)
#pragma unroll
        for (int j = 0; j < 16; ++j) if ((j & st) == 0) { const unsigned hi = umax_(c[j], c[j + st]), lo = umin_(c[j], c[j + st]); c[j] = hi; c[j + st] = lo; }
}


constexpr int OE_N = 63;
constexpr int OE_I[OE_N] = {0,2,0,1,1,4,6,4,5,5,0,2,2,1,3,3,1,3,5,8,10,8,9,9,12,14,12,13,13,8,10,10,9,11,11,9,11,13,0,4,4,2,6,6,2,6,10,1,5,5,3,7,7,3,7,11,1,3,5,7,9,11,13};
constexpr int OE_J[OE_N] = {1,3,2,3,2,5,7,6,7,6,4,6,4,5,7,5,2,4,6,9,11,10,11,10,13,15,14,15,14,12,14,12,13,15,13,10,12,14,8,12,8,10,14,10,4,8,12,9,13,9,11,15,11,5,9,13,2,4,6,8,10,12,14};
__device__ __forceinline__ void sort_desc16(unsigned (&c)[16]) {
#pragma unroll
    for (int n = 0; n < OE_N; ++n) { const unsigned hi = umax_(c[OE_I[n]], c[OE_J[n]]), lo = umin_(c[OE_I[n]], c[OE_J[n]]); c[OE_I[n]] = hi; c[OE_J[n]] = lo; }
}
__device__ __forceinline__ void merge_desc16(unsigned (&a)[16], const unsigned (&b)[16]) {
#pragma unroll
    for (int j = 0; j < 16; ++j) a[j] = umax_(a[j], b[15 - j]);
    bitonic_desc16(a);
}
constexpr int CAND_N = 50;
constexpr int CAND_I[64] = {0,0,0,0,0,0,0,0,0,0,0,0,0,0,0,0,1,1,1,1,1,1,1,1,2,2,2,2,2,3,3,3,3,4,4,4,5,5,6,6,7,7,8,9,10,11,12,13,14,15,0,0,0,0,0,0,0,0,0,0,0,0,0,0};
constexpr int CAND_J[64] = {0,1,2,3,4,5,6,7,8,9,10,11,12,13,14,15,0,1,2,3,4,5,6,7,0,1,2,3,4,0,1,2,3,0,1,2,0,1,0,1,0,1,0,0,0,0,0,0,0,0,0,0,0,0,0,0,0,0,0,0,0,0,0,0};
struct Epi6q {
    static constexpr bool PERM = false, AFTER_DRAIN = false; Params P;
    __device__ __forceinline__ void operator()(const Acc8& acc, const pg8::Unit& u, int wr, int wc, int fr, int fq) const {
#pragma unroll
        for (int ai = 0; ai < 2; ++ai)
#pragma unroll
            for (int m = 0; m < 4; ++m) { const int t = u.pm * 256 + ai * 128 + wr * 64 + m * 16 + fr;
                const float rs = wsp<float>(P, O_RSTDH)[t];
#pragma unroll
                for (int bj = 0; bj < 2; ++bj)
#pragma unroll
                    for (int n = 0; n < 2; ++n) { const int c = u.pn * 256 + bj * 128 + wc * 32 + n * 16 + 4 * fq;
                        *(u32x2*)(wsp<bf16_t>(P, O_GT) + (size_t)t * D_ + c) = pack4(acc[ai][bj][m][n] * rs); }
                asm volatile("" ::: "memory"); }
    }
};
__device__ __forceinline__ void p6_topk(const Params& P, int pm, int pn, LAS unsigned char* lds, int tid) {
    const int lane = tid & 63, wid = tid >> 6, fr = lane & 15, fq = lane >> 4;
    LAS unsigned* sk = (LAS unsigned*)lds; const int row = tid >> 1, part = tid & 1;
    const bf16_t* QT = wsp<bf16_t>(P, O_GT) + (size_t)(pm * 256) * D_;
#pragma unroll 1
    for (int hh = 0; hh < 2; ++hh) {
        unsigned A[2][16];
#pragma unroll
        for (int half = 0; half < 2; ++half) {
            {
                const bf16_t* kb = wsp<bf16_t>(P, half ? O_K2B : O_K1B);
                bf16x8 qfr[2][2];
#pragma unroll
                for (int ks = 0; ks < 2; ++ks)
#pragma unroll
                    for (int tf = 0; tf < 2; ++tf) qfr[ks][tf] = *(const bf16x8*)(QT + (size_t)(32 * wid + 16 * tf + fr) * D_ + (pn * 2 + hh) * 128 + half * 64 + ks * 32 + fq * 8);
                f32x4 sacc[8][2];
#pragma unroll
                for (int kf = 0; kf < 8; ++kf) { sacc[kf][0] = (f32x4){0.f, 0.f, 0.f, 0.f}; sacc[kf][1] = (f32x4){0.f, 0.f, 0.f, 0.f}; }
#pragma unroll
                for (int ks = 0; ks < 2; ++ks)
#pragma unroll
                    for (int kf = 0; kf < 8; ++kf) { const bf16x8 kfr = *(const bf16x8*)(kb + (kf * 16 + fr) * 64 + ks * 32 + fq * 8);
                        sacc[kf][0] = MFMA16(kfr, qfr[ks][0], sacc[kf][0]); sacc[kf][1] = MFMA16(kfr, qfr[ks][1], sacc[kf][1]); }
#pragma unroll
                for (int tf = 0; tf < 2; ++tf) { LAS unsigned* sp = sk + (32 * wid + 16 * tf + fr) * 132 + 4 * fq; const unsigned kl = (unsigned)(4 * fq);
#pragma unroll
                    for (int kf = 0; kf < 8; ++kf) { u32x4 w;
#pragma unroll
                        for (int r = 0; r < 4; ++r) w[r] = (f2key(sacc[kf][tf][r]) & ~127u) | (kl + (unsigned)(kf * 16 + r));
                        *(LAS u32x4*)(sp + kf * 16) = w; } }
            }
            __syncthreads();
            unsigned kk[4][16];
#pragma unroll
            for (int gi = 0; gi < 4; ++gi)
#pragma unroll
                for (int c = 0; c < 4; ++c) { const u32x4 v = *(const LAS u32x4*)(sk + row * 132 + gi * 32 + part * 16 + 4 * c); kk[gi][4 * c] = v[0]; kk[gi][4 * c + 1] = v[1]; kk[gi][4 * c + 2] = v[2]; kk[gi][4 * c + 3] = v[3]; }
#pragma unroll
            for (int gi = 0; gi < 4; ++gi) sort_desc16(kk[gi]);
            merge_desc16(kk[0], kk[1]); merge_desc16(kk[2], kk[3]); merge_desc16(kk[0], kk[2]);
            unsigned c[16];
#pragma unroll
            for (int j = 0; j < 16; ++j) c[j] = umax_(kk[0][j], (unsigned)DPP_I(kk[0][15 - j], 0xB1));
            bitonic_desc16(c);
#pragma unroll
            for (int j = 0; j < 16; ++j) A[half][j] = c[j];
            __syncthreads();
        }
        float fa[16], fb[16];
#pragma unroll
        for (int j = 0; j < 16; ++j) { fa[j] = key2f(A[0][j] & ~127u); fb[j] = key2f(A[1][j] & ~127u); }
        unsigned x0[16], x1[16];
#pragma unroll
        for (int m = 0; m < 16; ++m) {
            const unsigned a0 = (m < CAND_N) ? ((f2key(fa[CAND_I[m]] + fb[CAND_J[m]]) & ~255u) | (unsigned)(CAND_I[m] * 16 + CAND_J[m])) : 0u;
            const unsigned a1 = (m + 16 < CAND_N) ? ((f2key(fa[CAND_I[m + 16]] + fb[CAND_J[m + 16]]) & ~255u) | (unsigned)(CAND_I[m + 16] * 16 + CAND_J[m + 16])) : 0u;
            const unsigned b0 = (m + 32 < CAND_N) ? ((f2key(fa[CAND_I[m + 32]] + fb[CAND_J[m + 32]]) & ~255u) | (unsigned)(CAND_I[m + 32] * 16 + CAND_J[m + 32])) : 0u;
            const unsigned b1 = (m + 48 < CAND_N) ? ((f2key(fa[CAND_I[m + 48]] + fb[CAND_J[m + 48]]) & ~255u) | (unsigned)(CAND_I[m + 48] * 16 + CAND_J[m + 48])) : 0u;
            x0[m] = part ? b0 : a0; x1[m] = part ? b1 : a1; }
        sort_desc16(x0); sort_desc16(x1); merge_desc16(x0, x1);
        unsigned C[16];
#pragma unroll
        for (int j = 0; j < 16; ++j) C[j] = umax_(x0[j], (unsigned)DPP_I(x0[15 - j], 0xB1));
        bitonic_desc16(C);
        if (part == 0) {
            const int t = pm * 256 + row, h = pn * 2 + hh; float ev[16]; float den = 0.f; const float top0 = key2f(C[0] & ~255u); unsigned eo[16];
            unsigned ia4[4], ib4[4];
#pragma unroll
            for (int q = 0; q < 4; ++q) {
                ia4[q] = (__builtin_amdgcn_perm(A[0][4 * q + 1], A[0][4 * q], 0x0c0c0400u) | __builtin_amdgcn_perm(A[0][4 * q + 3], A[0][4 * q + 2], 0x04000c0cu)) & 0x7f7f7f7fu;
                ib4[q] = (__builtin_amdgcn_perm(A[1][4 * q + 1], A[1][4 * q], 0x0c0c0400u) | __builtin_amdgcn_perm(A[1][4 * q + 3], A[1][4 * q + 2], 0x04000c0cu)) & 0x7f7f7f7fu; }
#pragma unroll
            for (int k = 0; k < 16; ++k) { const unsigned pos = C[k] & 255u, pi = pos >> 4, pj = pos & 15u;
                const unsigned la = __builtin_amdgcn_perm(ia4[1], ia4[0], pi & 7u), ha = __builtin_amdgcn_perm(ia4[3], ia4[2], pi & 7u);
                const unsigned lb_ = __builtin_amdgcn_perm(ib4[1], ib4[0], pj & 7u), hb = __builtin_amdgcn_perm(ib4[3], ib4[2], pj & 7u);
                const unsigned ia = ((pi & 8u) ? ha : la) & 255u, ib = ((pj & 8u) ? hb : lb_) & 255u;
                eo[k] = ia * 128u + ib; ev[k] = __expf(key2f(C[k] & ~255u) - top0); den += ev[k]; }
            const float id = 1.0f / den;
            unsigned short* ep = wsp<unsigned short>(P, O_EIDX) + (size_t)t * 128 + 2 * h; float* gp = wsp<float>(P, O_GATE) + (size_t)t * 128 + h * 16;
#pragma unroll
            for (int r = 0; r < 16; ++r) ep[(r & 7) * 16 + (r >> 3)] = (unsigned short)eo[r];
#pragma unroll
            for (int k = 0; k < 4; ++k) *(f32x4*)(gp + 4 * k) = (f32x4){ev[4 * k] * id, ev[4 * k + 1] * id, ev[4 * k + 2] * id, ev[4 * k + 3] * id};
        }
    }
}

typedef short v4i16_t __attribute__((ext_vector_type(4)));
__device__ __forceinline__ v4i16_t vtr(const LAS unsigned char* p) { return __builtin_amdgcn_ds_read_tr16_b64_v4i16((LAS v4i16_t*)p); }
template <int DQK, int NQB, bool BAND>
__device__ __forceinline__ void attn_item(const bf16_t* __restrict__ Qb, int qrs, const bf16_t* __restrict__ Kb, int krs, const bf16_t* __restrict__ Vb, int vrs,
                          int q0, int kt_begin, int kt_end, LAS unsigned char* smem, int tid,
                          bf16_t* __restrict__ Ob, int ors, float* __restrict__ statb, int srs) {
    constexpr int KS = DQK / 32, KP = DQK * 2 + 16, CPR = DQK / 8, KT = 128, NKC = KT * CPR, NKI = NKC / 512, VP = 160, STG = KT * KP + KT * VP;
    const int lane = tid & 63, w = tid >> 6, fr = lane & 15, fq = lane >> 4;
    bf16x8 qf[NQB][KS];
#pragma unroll
    for (int qb = 0; qb < NQB; ++qb)
#pragma unroll
        for (int ks = 0; ks < KS; ++ks) qf[qb][ks] = *(const bf16x8*)(Qb + (size_t)(q0 + 16 * (w * NQB + qb) + fr) * qrs + ks * 32 + fq * 8);
    f32x4 oacc[4][NQB]; float mrun[NQB], lrun[NQB];
#pragma unroll
    for (int qb = 0; qb < NQB; ++qb) { mrun[qb] = 0.f; lrun[qb] = 0.f;
#pragma unroll
        for (int df = 0; df < 4; ++df) oacc[df][qb] = (f32x4){0.f, 0.f, 0.f, 0.f}; }
    u32x4 rk[NKI], rv[2];
    auto gload = [&](int kt) {
#pragma unroll
        for (int i = 0; i < NKI; ++i) { const int c = tid + 512 * i, row = c / CPR, ch = c % CPR; if (kt + row < kt_end) rk[i] = *(const u32x4*)(Kb + (size_t)(kt + row) * krs + ch * 8); }
#pragma unroll
        for (int i = 0; i < 2; ++i) { const int c = tid + 512 * i, row = c >> 3, ch = c & 7; if (kt + row < kt_end) rv[i] = *(const u32x4*)(Vb + (size_t)(kt + row) * vrs + ch * 8); }
    };
    auto sstore = [&](int buf) {
        LAS unsigned char* Kw = smem + buf * STG; LAS unsigned char* Vw = Kw + KT * KP;
#pragma unroll
        for (int i = 0; i < NKI; ++i) { const int c = tid + 512 * i, row = c / CPR, ch = c % CPR; *(LAS u32x4*)(Kw + row * KP + ch * 16) = rk[i]; }
#pragma unroll
        for (int i = 0; i < 2; ++i) { const int c = tid + 512 * i, row = c >> 3, ch = c & 7; *(LAS u32x4*)(Vw + row * VP + ch * 16) = rv[i]; }
    };
#pragma unroll
    for (int i = 0; i < NKI; ++i) rk[i] = (u32x4){0u, 0u, 0u, 0u};
    rv[0] = rv[1] = (u32x4){0u, 0u, 0u, 0u};
    gload(kt_begin); sstore(0); __syncthreads();
    int it = 0;
    for (int kt0 = kt_begin; kt0 < kt_end; kt0 += KT, ++it) {
        const bool more = kt0 + KT < kt_end;
        if (more) gload(kt0 + KT);
#pragma unroll
        for (int sub = 0; sub < KT / 64; ++sub) {
        const int kt = kt0 + 64 * sub;
        if (kt >= kt_end) break;
        const LAS unsigned char* Ks = smem + (it & 1) * STG + sub * 64 * KP; const LAS unsigned char* Vs = smem + (it & 1) * STG + KT * KP + sub * 64 * VP;
        bool run = true;
        if (BAND) { const int qb0 = q0 + 16 * w; run = (kt >= qb0 - 112) && (kt <= qb0 + 64); }
        if (run) {
            f32x4 sacc[4][NQB];
            __builtin_amdgcn_s_setprio(1);
#pragma unroll
            for (int kf = 0; kf < 4; ++kf) {
#pragma unroll
                for (int qb = 0; qb < NQB; ++qb) { const float nm = -mrun[qb]; sacc[kf][qb] = (f32x4){nm, nm, nm, nm}; }
#pragma unroll
                for (int ks = 0; ks < KS; ++ks) { const bf16x8 kfr = *(const LAS bf16x8*)(Ks + (16 * kf + fr) * KP + ks * 64 + fq * 16);
#pragma unroll
                    for (int qb = 0; qb < NQB; ++qb) sacc[kf][qb] = MFMA16(kfr, qf[qb][ks], sacc[kf][qb]); }
            }
            __builtin_amdgcn_s_setprio(0);
            bf16x8 pf[NQB][2];
#pragma unroll
            for (int qb = 0; qb < NQB; ++qb) {
                if (BAND) { const int qpos = q0 + 16 * (w * NQB + qb) + fr;
#pragma unroll
                    for (int kf = 0; kf < 4; ++kf)
#pragma unroll
                        for (int r = 0; r < 4; ++r) { const int dlt = qpos - (kt + 16 * kf + 4 * fq + r); if (dlt > 64 || dlt < -64) sacc[kf][qb][r] = -1e30f; } }
                float ps = 0.f; unsigned pw[4][2];
#pragma unroll
                for (int kf = 0; kf < 4; ++kf) { const float p0 = fexp2(sacc[kf][qb][0]), p1 = fexp2(sacc[kf][qb][1]), p2 = fexp2(sacc[kf][qb][2]), p3 = fexp2(sacc[kf][qb][3]);
                    ps += (p0 + p1) + (p2 + p3); pw[kf][0] = pack2(p0, p1); pw[kf][1] = pack2(p2, p3); }
                if (!__all(ps <= ATT_PMAX)) {
                    float mx = -1e30f;
#pragma unroll
                    for (int kf = 0; kf < 4; ++kf) mx = fmaxf(mx, fmaxf(fmaxf(sacc[kf][qb][0], sacc[kf][qb][1]), fmaxf(sacc[kf][qb][2], sacc[kf][qb][3])));
                    mx = fmaxf(mx, __shfl_xor(mx, 16)); mx = fmaxf(mx, __shfl_xor(mx, 32));
                    const float delta = fmaxf(mx, 0.f), alpha = fexp2(-delta);
                    mrun[qb] += delta; lrun[qb] *= alpha;
#pragma unroll
                    for (int df = 0; df < 4; ++df) oacc[df][qb] = oacc[df][qb] * alpha;
                    ps = 0.f;
#pragma unroll
                    for (int kf = 0; kf < 4; ++kf) { const float p0 = fexp2(sacc[kf][qb][0] - delta), p1 = fexp2(sacc[kf][qb][1] - delta), p2 = fexp2(sacc[kf][qb][2] - delta), p3 = fexp2(sacc[kf][qb][3] - delta);
                        ps += (p0 + p1) + (p2 + p3); pw[kf][0] = pack2(p0, p1); pw[kf][1] = pack2(p2, p3); }
                }
                lrun[qb] += ps;
#pragma unroll
                for (int c = 0; c < 2; ++c) { const u32x4 t4 = (u32x4){pw[2 * c][0], pw[2 * c][1], pw[2 * c + 1][0], pw[2 * c + 1][1]}; pf[qb][c] = *(const bf16x8*)&t4; }
            }
            __builtin_amdgcn_s_setprio(1);
#pragma unroll
            for (int c = 0; c < 2; ++c)
#pragma unroll
                for (int df = 0; df < 4; ++df) {
                    const LAS unsigned char* vp = Vs + (32 * c + 4 * fq + (fr >> 2)) * VP + (16 * df + 4 * (fr & 3)) * 2;
                    const v4i16_t lo = vtr(vp), hi = vtr(vp + 16 * VP);
                    const bf16x8 vfr = (bf16x8){lo[0], lo[1], lo[2], lo[3], hi[0], hi[1], hi[2], hi[3]};
#pragma unroll
                    for (int qb = 0; qb < NQB; ++qb) oacc[df][qb] = MFMA16(vfr, pf[qb][c], oacc[df][qb]);
                }
            __builtin_amdgcn_s_setprio(0);
        }
        }
        if (more) sstore((it + 1) & 1);
        __syncthreads();
    }
#pragma unroll
    for (int qb = 0; qb < NQB; ++qb) {
        const float l = quad_sum(lrun[qb]), il = 1.0f / l; const int qi = q0 + 16 * (w * NQB + qb) + fr; float ss = 0.f;
#pragma unroll
        for (int df = 0; df < 4; ++df) { const f32x4 v = oacc[df][qb] * il; ss += v[0] * v[0] + v[1] * v[1] + v[2] * v[2] + v[3] * v[3]; *(u32x2*)(Ob + (size_t)qi * ors + 16 * df + 4 * fq) = pack4(v); }
        if (BAND) { if (fq == 0) statb[(size_t)qi * srs] = mrun[qb] + log2f(l); }
        else { ss = quad_sum(ss); if (fq == 0) statb[(size_t)qi * srs] = ss; }
    }
}
constexpr int N_MLA_ITEMS = 512, N_DIL_ITEMS = 3072;
__device__ __forceinline__ void attn_dispatch(const Params& P, int item, LAS unsigned char* smem, int tid) {
    bf16_t* omla = (bf16_t*)P.out; bf16_t* opart = (bf16_t*)P.out + (size_t)T_ * 512;
    if (item < N_MLA_ITEMS) {
        const int bh = item >> 3, qt = item & 7, b = bh >> 3, h = bh & 7;
        attn_item<96, 2, false>(wsp<bf16_t>(P, O_QM) + (size_t)bh * S_ * 96, 96, wsp<bf16_t>(P, O_KM) + (size_t)bh * S_ * 96, 96, wsp<bf16_t>(P, O_VM) + (size_t)bh * S_ * 64, 64,
                                qt * 256, 0, S_, smem, tid, omla + (size_t)b * S_ * 512 + h * 64, 512, wsp<float>(P, O_SSMLA) + (size_t)b * S_ * 8 + h, 8);
    } else {
        const int it = item - N_MLA_ITEMS, p = it >> 10, rem = it & 1023, bh = rem >> 4, qt = rem & 15, b = bh >> 3, h = bh & 7;
        const int dil = dil_of(p), L = S_ / dil, tpr = L >> 7, res = qt / tpr, j0 = (qt - res * tpr) * 128;
        const int kb = j0 - 64 < 0 ? 0 : j0 - 64, ke = j0 + 192 > L ? L : j0 + 192;
        attn_item<64, 1, true>(wsp<bf16_t>(P, O_QD) + ((size_t)bh * S_ + res) * 64, dil * 64, wsp<bf16_t>(P, O_KD) + ((size_t)bh * S_ + res) * 64, dil * 64,
                               wsp<bf16_t>(P, O_VD) + ((size_t)bh * S_ + res) * 64, dil * 64,
                               j0, kb, ke, smem, tid, opart + (size_t)p * T_ * 512 + ((size_t)b * S_ + res) * 512 + h * 64, dil * 512,
                               wsp<float>(P, O_LSE) + ((size_t)p * T_ + (size_t)b * S_ + res) * 8 + h, dil * 8);
    }
}

__device__ __forceinline__ void merge_rows(const Params& P, const bf16_t* omla, const bf16_t* opart, long gwave, long gwaves, int lane, long tend = T_, long tstride = 0) {
    if (tstride == 0) tstride = gwaves;
    for (long t = gwave; t < tend; t += tstride) {
        const int h = lane >> 3;
        const float* lse = wsp<float>(P, O_LSE);
        const float l0 = lse[((size_t)0 * T_ + t) * 8 + h], l1 = lse[((size_t)1 * T_ + t) * 8 + h], l2 = lse[((size_t)2 * T_ + t) * 8 + h];
        const float mx = fmaxf(l0, fmaxf(l1, l2)); float w0 = exp2f(l0 - mx), w1 = exp2f(l1 - mx), w2 = exp2f(l2 - mx); const float iw = 1.0f / (w0 + w1 + w2); w0 *= iw; w1 *= iw; w2 *= iw;
        const u32x4 a0 = *(const u32x4*)(opart + (size_t)0 * T_ * 512 + (size_t)t * 512 + lane * 8), a1 = *(const u32x4*)(opart + (size_t)1 * T_ * 512 + (size_t)t * 512 + lane * 8),
                    a2 = *(const u32x4*)(opart + (size_t)2 * T_ * 512 + (size_t)t * 512 + lane * 8);
        float od[8]; float ssd = 0.f;
#pragma unroll
        for (int j = 0; j < 4; ++j) { od[2 * j] = w0 * bflo(a0[j]) + w1 * bflo(a1[j]) + w2 * bflo(a2[j]); od[2 * j + 1] = w0 * bfhi(a0[j]) + w1 * bfhi(a1[j]) + w2 * bfhi(a2[j]);
            ssd += od[2 * j] * od[2 * j] + od[2 * j + 1] * od[2 * j + 1]; }
        ssd = wave_sum(ssd); const float rd = rsqrtf(ssd * (1.0f / 512.0f) + EPS_);
        const float rm = rstd_from(wsp<float>(P, O_SSMLA) + (size_t)t * 8, 8, 1.0f / 512.0f);
        const u32x4 am = *(const u32x4*)(omla + (size_t)t * 512 + lane * 8);
        bf16_t* mx_ = wsp<bf16_t>(P, O_MIXED) + (size_t)t * D_;
        *(u32x4*)(mx_ + lane * 8) = (u32x4){pack2(bflo(am[0]) * rm, bfhi(am[0]) * rm), pack2(bflo(am[1]) * rm, bfhi(am[1]) * rm), pack2(bflo(am[2]) * rm, bfhi(am[2]) * rm), pack2(bflo(am[3]) * rm, bfhi(am[3]) * rm)};
        *(u32x4*)(mx_ + 512 + lane * 8) = (u32x4){pack2(od[0] * rd, od[1] * rd), pack2(od[2] * rd, od[3] * rd), pack2(od[4] * rd, od[5] * rd), pack2(od[6] * rd, od[7] * rd)};
    }
}
__device__ __forceinline__ void final_rows(const Params& P, long gwave, long gwaves, int lane, long tend = T_, long tstride = 0) {
    if (tstride == 0) tstride = gwaves;
    for (long t = gwave; t < tend; t += tstride) {
        const float rs = rstd_from(wsp<float>(P, O_SSQ3) + (size_t)t * 32, 32, 1.0f / 1024.0f);
        float* o = P.out + (size_t)t * D_;
#pragma unroll
        for (int i = 0; i < 4; ++i) { f32x4 v = *(f32x4*)(o + i * 256 + lane * 4); const f32x4 g = *(const f32x4*)(P.g_final + i * 256 + lane * 4);
            v[0] *= rs * g[0]; v[1] *= rs * g[1]; v[2] *= rs * g[2]; v[3] *= rs * g[3]; *(f32x4*)(o + i * 256 + lane * 4) = v; }
    }
}
__device__ __forceinline__ float wave_max(float v) {
    v = fmaxf(v, DPP_F(v, 0xB1)); v = fmaxf(v, DPP_F(v, 0x4E)); v = fmaxf(v, DPP_F(v, 0x141)); v = fmaxf(v, DPP_F(v, 0x140));
    v = fmaxf(v, __shfl_xor(v, 16)); v = fmaxf(v, __shfl_xor(v, 32));
    return v;
}
__device__ __forceinline__ unsigned q8(float v, float inv, int off) { return (unsigned)((int)rintf(v * inv) + off) & 0xffu; }
__device__ __forceinline__ void prep_tables_q(const Params& P, long gwave, long gwaves, int lane) {
    for (long r = gwave; r < 32768; r += gwaves) {
        const bool isv = r >= 16384; const int e = (int)(r & 16383);
        const float* src = (isv ? P.peer_v : P.peer_u) + (size_t)e * D_ + lane * 16;
        f32x4 a[4]; float am = 0.f;
#pragma unroll
        for (int i = 0; i < 4; ++i) { a[i] = *(const f32x4*)(src + 4 * i); if (!isv) a[i] = a[i] * *(const f32x4*)(P.g_ffn + lane * 16 + 4 * i); am = fmaxf(am, fmaxf(fmaxf(fabsf(a[i][0]), fabsf(a[i][1])), fmaxf(fabsf(a[i][2]), fabsf(a[i][3])))); }
        am = wave_max(am);
        const float inv = am > 0.f ? 127.0f / am : 0.f; const int off = 0;
        u32x4 w;
#pragma unroll
        for (int i = 0; i < 4; ++i) w[i] = q8(a[i][0], inv, off) | (q8(a[i][1], inv, off) << 8) | (q8(a[i][2], inv, off) << 16) | (q8(a[i][3], inv, off) << 24);
        *(u32x4*)(P.ws + (isv ? O_VQ : O_UQ) + ((size_t)(lane >> 3) * 16384 + e) * 128 + (lane & 7) * 16) = w;
        if (lane == 0) wsp<float>(P, isv ? O_VS : O_US)[e] = am * (1.0f / 127.0f);
    }
}
__device__ __forceinline__ void p6_xq(const Params& P, int pm, int pn, int tid) {
    const int sub = tid & 15, tr = tid >> 4;
#pragma unroll 2
    for (int it = 0; it < 8; ++it) {
        const int t = pm * 256 + it * 32 + tr;
        const bf16_t* hp = wsp<bf16_t>(P, O_HG) + (size_t)t * D_ + pn * 256 + sub * 16;
        const u32x4 h0 = *(const u32x4*)hp, h1 = *(const u32x4*)(hp + 8);
        const float inv = wsp<float>(P, O_RSTDH)[t] * (127.0f * 256.0f / (5.5f * 32767.0f)), c = 128.0f / 32767.0f;
        float xv[16];
#pragma unroll
        for (int q = 0; q < 4; ++q) { xv[2 * q] = bflo(h0[q]); xv[2 * q + 1] = bfhi(h0[q]); xv[8 + 2 * q] = bflo(h1[q]); xv[8 + 2 * q + 1] = bfhi(h1[q]); }
        u32x4 xq;
#pragma unroll
        for (int q = 0; q < 4; ++q) { const unsigned w0 = __builtin_bit_cast(unsigned, __builtin_amdgcn_cvt_pknorm_i16(fmaf(xv[4 * q], inv, c), fmaf(xv[4 * q + 1], inv, c)));
            const unsigned w1 = __builtin_bit_cast(unsigned, __builtin_amdgcn_cvt_pknorm_i16(fmaf(xv[4 * q + 2], inv, c), fmaf(xv[4 * q + 3], inv, c)));
            xq[q] = __builtin_amdgcn_perm(w1, w0, 0x07050301u); }
        *(u32x4*)(P.ws + O_XQ + (size_t)t * D_ + pn * 256 + sub * 16) = xq;
    }
}
struct P7aMeta { u32x4 id0, id1, xq; float rs; };
__device__ __forceinline__ unsigned rowoff(const u32x4& a, const u32x4& b, int i, unsigned j16) {
    const unsigned w = (i < 8) ? a[(i >> 1) & 3] : b[(i >> 1) & 3]; unsigned r;
    if (i & 1) asm("v_mad_u32_u16 %0, %1, %2, %3 op_sel:[1,0,0,0]" : "=v"(r) : "v"(w), "s"(128u), "v"(j16));
    else       asm("v_mad_u32_u16 %0, %1, %2, %3 op_sel:[0,0,0,0]" : "=v"(r) : "v"(w), "s"(128u), "v"(j16));
    return r; }
__device__ __forceinline__ int dot4z(unsigned a, unsigned b) { int d; asm("v_dot4_i32_i8 %0, %1, %2, 0" : "=v"(d) : "v"(a), "v"(b)); return d; }
__device__ __forceinline__ unsigned id16(const u32x4& a, const u32x4& b, int i) { const unsigned w = (i < 8) ? a[(i >> 1) & 3] : b[(i >> 1) & 3]; return (i & 1) ? (w >> 16) : (w & 0xffffu); }
__device__ __forceinline__ void p7a_loop(const Params& P, int xs, int lane, int t0, int tstride) {
    const int g = lane >> 3, j = lane & 7;
    const unsigned char* UQ = P.ws + O_UQ + (size_t)xs * 16384 * 128; const unsigned j16 = (unsigned)j * 16u;
    auto META = [&](int t, P7aMeta& m) {
        const unsigned short* ip = wsp<unsigned short>(P, O_EIDX) + (size_t)t * 128 + g * 16; m.id0 = *(const u32x4*)ip; m.id1 = *(const u32x4*)(ip + 8);
        m.xq = *(const u32x4*)(P.ws + O_XQ + (size_t)t * D_ + xs * 128 + j * 16); m.rs = wsp<float>(P, O_RSTDH)[t]; };
    auto ISSUEQ = [&](const P7aMeta& m, u32x4 (&rows)[16], int q) {
#pragma unroll
        for (int i = 4 * q; i < 4 * q + 4; ++i) rows[i] = *(const u32x4*)(UQ + rowoff(m.id0, m.id1, i, j16)); };
    auto COMPQ = [&](const P7aMeta& m, const u32x4 (&rows)[16], int (&acc)[16], int q) {
#pragma unroll
        for (int i = 4 * q; i < 4 * q + 4; ++i) { int d = dot4z(rows[i][0], m.xq[0]); d = __builtin_amdgcn_sdot4((int)rows[i][1], (int)m.xq[1], d, false);
            d = __builtin_amdgcn_sdot4((int)rows[i][2], (int)m.xq[2], d, false); acc[i] = __builtin_amdgcn_sdot4((int)rows[i][3], (int)m.xq[3], d, false); } };
    auto FINISH = [&](int t, const P7aMeta& m, const int (&acc)[16]) {
        const float sx = (5.5f / 127.0f) / m.rs;
        int b8[8], c4[4], d2[2];
        { const bool hi = (j & 4) != 0;
#pragma unroll
          for (int m2 = 0; m2 < 8; ++m2) { const int send = hi ? acc[m2] : acc[m2 + 8], keep = hi ? acc[m2 + 8] : acc[m2]; b8[m2] = keep + DPP_I(send, 0x141); } }
        { const bool hi = (j & 2) != 0;
#pragma unroll
          for (int m2 = 0; m2 < 4; ++m2) { const int send = hi ? b8[m2] : b8[m2 + 4], keep = hi ? b8[m2 + 4] : b8[m2]; c4[m2] = keep + DPP_I(send, 0x4E); } }
        { const bool hi = (j & 1) != 0;
#pragma unroll
          for (int m2 = 0; m2 < 2; ++m2) { const int send = hi ? c4[m2] : c4[m2 + 2], keep = hi ? c4[m2 + 2] : c4[m2]; d2[m2] = keep + DPP_I(send, 0xB1); } }
        bf16_t* part = t < T_ ? (bf16_t*)P.out + ((size_t)xs * T_ + t) * 128 : wsp<bf16_t>(P, O_DUMMY);
#pragma unroll
        for (int m2 = 0; m2 < 2; ++m2) part[16 * j + 8 * m2 + g] = f2bf((float)d2[m2] * sx); };
    auto STEP = [&](int t, const P7aMeta& mc, const P7aMeta& mn, u32x4 (&rows)[16]) {
        int acc[16];
#pragma unroll
        for (int q = 0; q < 4; ++q) { COMPQ(mc, rows, acc, q); __builtin_amdgcn_sched_barrier(0); ISSUEQ(mn, rows, q); __builtin_amdgcn_sched_barrier(0); }
        FINISH(t, mc, acc); };
    P7aMeta m0, m1, m2, m3; m0.id0 = m0.id1 = m0.xq = (u32x4){0u, 0u, 0u, 0u}; m0.rs = 1.f; m1 = m0; m2 = m0; m3 = m0;
    u32x4 rA[16], rB[16];
    if (t0 >= T_) return;
    int t = t0;
    auto TCL = [&](int tt) { return tt < T_ ? tt : t0; };
    META(TCL(t), m0); META(TCL(t + tstride), m1); META(TCL(t + 2 * tstride), m2);
    __builtin_amdgcn_sched_barrier(0);
#pragma unroll
    for (int q = 0; q < 4; ++q) { ISSUEQ(m0, rA, q); __builtin_amdgcn_sched_barrier(0); }
#pragma unroll
    for (int q = 0; q < 4; ++q) { ISSUEQ(m1, rB, q); __builtin_amdgcn_sched_barrier(0); }
    const int nst = (T_ - t0 + tstride - 1) / tstride;
    for (int it = 0; it < nst; it += 4) {
        META(TCL(t + 3 * tstride), m3); STEP(t, m0, m2, rA); t += tstride;
        META(TCL(t + 3 * tstride), m0); STEP(t, m1, m3, rB); t += tstride;
        META(TCL(t + 3 * tstride), m1); STEP(t, m2, m0, rA); t += tstride;
        META(TCL(t + 3 * tstride), m2); STEP(t, m3, m1, rB); t += tstride;
    }
}
__device__ __forceinline__ void p7b_token(const Params& P, int t, int lane) {
    const float rs = wsp<float>(P, O_RSTDH)[t];
    float cf[2];
#pragma unroll
    for (int hf = 0; hf < 2; ++hf) { const int k = lane + 64 * hf; float s = 0.f;
#pragma unroll
        for (int x = 0; x < 8; ++x) s += bf2f(((const bf16_t*)P.out)[((size_t)x * T_ + t) * 128 + k]);
        const int e = wsp<unsigned short>(P, O_EIDX)[(size_t)t * 128 + (k & 7) * 16 + (k >> 3)]; const float a = rs * s * wsp<float>(P, O_US)[e];
        cf[hf] = wsp<float>(P, O_GATE)[(size_t)t * 128 + k] * 0.5f * a * (1.0f + erff(a * 0.70710678118654752f)) * wsp<float>(P, O_VS)[e]; }
    const float cmax = wave_max(fmaxf(fabsf(cf[0]), fabsf(cf[1])));
    const float inv = cmax > 0.f ? 127.0f / cmax : 0.f;
    asm volatile("s_waitcnt vmcnt(0)" ::: "memory");
    unsigned char* row = (unsigned char*)(wsp<float>(P, O_GATE) + (size_t)t * 128);
#pragma unroll
    for (int hf = 0; hf < 2; ++hf) { const int k = lane + 64 * hf; row[(k & 7) * 16 + (k >> 3)] = (unsigned char)(q8(cf[hf], inv, 0)); }
    if (lane == 0) *(float*)(row + 128) = cmax * (1.0f / 127.0f);
}
struct P7cMeta { u32x4 id0, id1, cw; float cs, h0, h1; };
__device__ __forceinline__ void p7c_loop(const Params& P, int xs, int lane, int t0, int tstride) {
    const int g = lane >> 3, j = lane & 7;
    const unsigned char* VQ = P.ws + O_VQ + (size_t)xs * 16384 * 128; const unsigned j16 = (unsigned)j * 16u;
    const int col = xs * 128 + 16 * j + 2 * g;
    auto META = [&](int t, P7cMeta& m) {
        const unsigned short* ip = wsp<unsigned short>(P, O_EIDX) + (size_t)t * 128 + g * 16; m.id0 = *(const u32x4*)ip; m.id1 = *(const u32x4*)(ip + 8);
        const unsigned char* crow = (const unsigned char*)(wsp<float>(P, O_GATE) + (size_t)t * 128); m.cw = *(const u32x4*)(crow + g * 16); m.cs = *(const float*)(crow + 128);
        const unsigned hw = *(const unsigned*)(wsp<bf16_t>(P, O_HG) + (size_t)t * D_ + col); m.h0 = bflo(hw); m.h1 = bfhi(hw); };
    auto ISSUEQ = [&](const P7cMeta& m, u32x4 (&rows)[16], int q) {
#pragma unroll
        for (int i = 4 * q; i < 4 * q + 4; ++i) rows[i] = *(const u32x4*)(VQ + rowoff(m.id0, m.id1, i, j16)); };
    auto COMPQ = [&](const P7cMeta& m, const u32x4 (&rows)[16], int (&acc)[16], int mg) {
#pragma unroll
        for (int d = 0; d < 4; ++d) {
            const unsigned R0 = rows[4 * mg][d], R1 = rows[4 * mg + 1][d], R2 = rows[4 * mg + 2][d], R3 = rows[4 * mg + 3][d];
            const unsigned t0_ = __builtin_amdgcn_perm(R1, R0, 0x06020400u), t1 = __builtin_amdgcn_perm(R1, R0, 0x07030501u);
            const unsigned t2 = __builtin_amdgcn_perm(R3, R2, 0x06020400u), t3 = __builtin_amdgcn_perm(R3, R2, 0x07030501u);
            const unsigned T0 = __builtin_amdgcn_perm(t2, t0_, 0x05040100u), T2 = __builtin_amdgcn_perm(t2, t0_, 0x07060302u);
            const unsigned T1 = __builtin_amdgcn_perm(t3, t1, 0x05040100u), T3 = __builtin_amdgcn_perm(t3, t1, 0x07060302u);
            if (mg == 0) { acc[4 * d] = dot4z(T0, m.cw[0]); acc[4 * d + 1] = dot4z(T1, m.cw[0]); acc[4 * d + 2] = dot4z(T2, m.cw[0]); acc[4 * d + 3] = dot4z(T3, m.cw[0]); }
            else { acc[4 * d] = __builtin_amdgcn_sdot4((int)T0, (int)m.cw[mg], acc[4 * d], false); acc[4 * d + 1] = __builtin_amdgcn_sdot4((int)T1, (int)m.cw[mg], acc[4 * d + 1], false);
                   acc[4 * d + 2] = __builtin_amdgcn_sdot4((int)T2, (int)m.cw[mg], acc[4 * d + 2], false); acc[4 * d + 3] = __builtin_amdgcn_sdot4((int)T3, (int)m.cw[mg], acc[4 * d + 3], false); }
        } };
    auto FINISH = [&](int t, const P7cMeta& m, const int (&acc)[16]) {
        int b8[8], c4[4], d2[2];
#pragma unroll
        for (int q = 0; q < 8; ++q) { const auto r = __builtin_amdgcn_permlane32_swap((unsigned)acc[q], (unsigned)acc[q + 8], false, false); b8[q] = (int)(r[0] + r[1]); }
#pragma unroll
        for (int q = 0; q < 4; ++q) { const auto r = __builtin_amdgcn_permlane16_swap((unsigned)b8[q], (unsigned)b8[q + 4], false, false); c4[q] = (int)(r[0] + r[1]); }
        { const bool hi = (g & 1) != 0;
#pragma unroll
          for (int q = 0; q < 2; ++q) { const int send = hi ? c4[q] : c4[q + 2], keep = hi ? c4[q + 2] : c4[q]; d2[q] = keep + DPP_I(send, 0x128); } }
        const bool ok = t < T_;
        const float y0 = m.h0 + (float)d2[0] * m.cs, y1 = m.h1 + (float)d2[1] * m.cs;
        *(unsigned*)(ok ? wsp<bf16_t>(P, O_HG) + (size_t)t * D_ + col : wsp<bf16_t>(P, O_DUMMY) + 2 * lane) = pack2(y0, y1);
        const float ss = wave_sum(y0 * y0 + y1 * y1);
        if (lane == 0) *(ok ? wsp<float>(P, O_SSQ2) + (size_t)t * 8 + xs : wsp<float>(P, O_DUMMY) + 256) = ss; };
    auto STEP = [&](int t, const P7cMeta& mc, const P7cMeta& mn, u32x4 (&rows)[16]) {
        int acc[16];
#pragma unroll
        for (int q = 0; q < 4; ++q) { COMPQ(mc, rows, acc, q); __builtin_amdgcn_sched_barrier(0); ISSUEQ(mn, rows, q); __builtin_amdgcn_sched_barrier(0); }
        FINISH(t, mc, acc); };
    P7cMeta m0{(u32x4){0u, 0u, 0u, 0u}, (u32x4){0u, 0u, 0u, 0u}, (u32x4){0u, 0u, 0u, 0u}, 0.f, 0.f, 0.f}, m1 = m0, m2 = m0, m3 = m0; u32x4 rA[16], rB[16];
    if (t0 >= T_) return;
    int t = t0;
    auto TCL = [&](int tt) { return tt < T_ ? tt : t0; };
    META(TCL(t), m0); META(TCL(t + tstride), m1); META(TCL(t + 2 * tstride), m2);
    __builtin_amdgcn_sched_barrier(0);
#pragma unroll
    for (int q = 0; q < 4; ++q) { ISSUEQ(m0, rA, q); __builtin_amdgcn_sched_barrier(0); }
#pragma unroll
    for (int q = 0; q < 4; ++q) { ISSUEQ(m1, rB, q); __builtin_amdgcn_sched_barrier(0); }
    const int nst = (T_ - t0 + tstride - 1) / tstride;
    for (int it = 0; it < nst; it += 4) {
        META(TCL(t + 3 * tstride), m3); STEP(t, m0, m2, rA); t += tstride;
        META(TCL(t + 3 * tstride), m0); STEP(t, m1, m3, rB); t += tstride;
        META(TCL(t + 3 * tstride), m1); STEP(t, m2, m0, rA); t += tstride;
        META(TCL(t + 3 * tstride), m2); STEP(t, m3, m1, rB); t += tstride;
    }
}
__global__ void __launch_bounds__(NTHR, 2) k_mega(Params P) {
    extern __shared__ __attribute__((aligned(16))) unsigned char smem_[];
    LAS unsigned char* lds = (LAS unsigned char*)smem_;
    const int tid = threadIdx.x, lane = tid & 63, wv = __builtin_amdgcn_readfirstlane(tid >> 6);
    const int G = gridDim.x, bid = blockIdx.x, xg = bid & 7, lb = bid >> 3, nlb = G >> 3;
    volatile LAS unsigned* st = (volatile LAS unsigned*)(lds + LDS_CTL);
    if (tid == 0) { st[0] = 0u; st[1] = 0u; st[2] = 0u; st[3] = 0u; }
    __syncthreads();
    XcdBarrier xb = xcd_barrier_post((unsigned*)(P.ws + O_BAR), st); unsigned bepoch = 0u;
    const long rw0 = (long)xg * 2048 + lb * NWAVE + wv, rwe = (long)xg * 2048 + 2048; const int rws = nlb * NWAVE;
    if (PH(0)) for (int rep = 0; rep < REP_P0; ++rep) {
    prep_weights(P, (long)bid * NTHR + tid, (long)G * NTHR); prep_weights_late(P, (long)bid * NTHR + tid, (long)G * NTHR);
    prep_rows(P, rw0, 0, opq_v(lane), rwe, rws); }
    xcd_barrier(xb, bepoch);
    if (PH(1)) for (int rep = 0; rep < REP_P1; ++rep)
    { pg8::Gemm g{wsp<bf16_t>(P, O_XB), wsp<bf16_t>(P, O_WIN), T_, NIN, opaque(D_)}; XSched S{xg, lb, nlb, NIN / 256}; Epi1 E{P};
      pg8::gemm_phase<Epi1, XSched, true, true>(lds, g, S, E);
      if (nlb == 32) { if (lb >= 8) prep_tables_q(P, (long)((xg * 24 + (lb - 8)) * NWAVE + wv), 192L * NWAVE, opq_v(lane)); }
      else prep_tables_q(P, (long)bid * NWAVE + wv, (long)G * NWAVE, opq_v(lane)); }
    xcd_barrier(xb, bepoch);
    if (PH(2)) for (int rep = 0; rep < REP_P2; ++rep) {
    { XSched S{xg, lb, nlb, 4}; pg8::Unit u; for (int i = 0; S.next(i, u); ++i) { if (tid < 256) rows_rstd(wsp<float>(P, O_SSQQ), 12, 1.0f / 384.0f, wsp<float>(P, O_RSTDQ), u.pm, tid);
          else rows_rstd(wsp<float>(P, O_SSQKV), 8, 1.0f / 256.0f, wsp<float>(P, O_RSTDKV), u.pm, tid - 256); } }
    { XSched S{xg, lb, nlb, 3}; pg8::Unit u; for (int i = 0; S.next(i, u); ++i) { if (tid < 256) rows_rstd(wsp<float>(P, O_SSQQ), 12, 1.0f / 384.0f, wsp<float>(P, O_RSTDQ), u.pm, tid); } }
    WG_PUBLISH();
    { pg8::Gemm g{wsp<bf16_t>(P, O_CQ), wsp<bf16_t>(P, O_WUQ), T_, 768, opaque(384)}; XSched S{xg, lb, nlb, 3}; Epi2a E{P};
      pg8::gemm_phase<Epi2a, XSched, true, true>(lds, g, S, E); }
    { pg8::Gemm g{wsp<bf16_t>(P, O_CKV), wsp<bf16_t>(P, O_WUKV), T_, 1024, opaque(256)}; XSched S{xg, lb, nlb, 4}; Epi2b E{P};
      pg8::gemm_phase<Epi2b, XSched, true, true>(lds, g, S, E); } }
    xcd_barrier(xb, bepoch);
    if (PH(3)) for (int rep = 0; rep < REP_P3; ++rep)
    for (int j = lb; j < 64 + 384; j += nlb) {
        int item;
        if (j < 64) item = (xg * 8 + (j >> 3)) * 8 + (j & 7);
        else { const int jj = j - 64, p = jj >> 7, r = jj & 127; item = N_MLA_ITEMS + p * 1024 + (xg * 8 + (r >> 4)) * 16 + (r & 15); }
        attn_dispatch(P, item, lds, opq_v(tid)); __syncthreads();
    }
    xcd_barrier(xb, bepoch);
    if (PH(4)) for (int rep = 0; rep < REP_P4; ++rep) {
    { const int ln = opq_v(lane); merge_rows(P, (const bf16_t*)P.out, (const bf16_t*)P.out + (size_t)T_ * 512, rw0, 0, ln, rwe, rws);
    } }
    xcd_barrier(xb, bepoch);
    if (PH(5)) for (int rep = 0; rep < REP_P5; ++rep)
    { pg8::Gemm g{wsp<bf16_t>(P, O_MIXED), wsp<bf16_t>(P, O_WOUT), T_, D_, opaque(D_)}; XSched S{xg, lb, nlb, 4}; Epi5 E{P};
      pg8::gemm_phase<Epi5, XSched, true, true>(lds, g, S, E); }
    xcd_barrier(xb, bepoch);
    if (PH(6)) for (int rep = 0; rep < REP_P6; ++rep) {
    { XSched S{xg, lb, nlb, 4}; pg8::Unit u; for (int i = 0; S.next(i, u); ++i) if (tid < 256) rows_rstd(wsp<float>(P, O_SSQH), 32, 1.0f / 1024.0f, wsp<float>(P, O_RSTDH), u.pm, tid); }
    WG_PUBLISH();
    { XSched S{xg, lb, nlb, 4}; pg8::Unit u; for (int i = 0; S.next(i, u); ++i) p6_xq(P, u.pm, u.pn, opq_v(tid)); }
    { pg8::Gemm g{wsp<bf16_t>(P, O_HG), wsp<bf16_t>(P, O_WPQ), T_, D_, opaque(D_)}; XSched S{xg, lb, nlb, 4}; Epi6q E{P};
      pg8::gemm_phase<Epi6q, XSched, true, true>(lds, g, S, E); }
    WG_PUBLISH();
    { XSched S{xg, lb, nlb, 4}; pg8::Unit u; for (int i = 0; S.next(i, u); ++i) p6_topk(P, u.pm, u.pn, lds, opq_v(tid)); } }
    xcd_barrier(xb, bepoch);
    if (PH(7)) for (int rep = 0; rep < REP_P7; ++rep)
    p7a_loop(P, xg, opq_v(lane), lb * NWAVE + wv, nlb * NWAVE);
    xcd_barrier(xb, bepoch);
    if (PH(7)) for (int t = bid * NWAVE + wv; t < T_; t += G * NWAVE) p7b_token(P, t, opq_v(lane));
    xcd_barrier(xb, bepoch);
    if (PH(7)) p7c_loop(P, xg, opq_v(lane), lb * NWAVE + wv, nlb * NWAVE);
    xcd_barrier(xb, bepoch);
    if (PH(8)) for (int rep = 0; rep < REP_P8; ++rep) {
    { XSched S{xg, lb, nlb, 4}; pg8::Unit u; for (int i = 0; S.next(i, u); ++i) if (tid < 256) rows_rstd(wsp<float>(P, O_SSQ2), 8, 1.0f / 1024.0f, wsp<float>(P, O_RSTD2), u.pm, tid); }
    WG_PUBLISH();
    { pg8::Gemm g{wsp<bf16_t>(P, O_HG), wsp<bf16_t>(P, O_WPG), T_, D_, opaque(D_)}; XSched S{xg, lb, nlb, 4}; Epi8a E{P};
      pg8::gemm_phase<Epi8a, XSched, true, true>(lds, g, S, E); }
    { pg8::Gemm g{wsp<bf16_t>(P, O_PB), wsp<bf16_t>(P, O_WPP), T_, D_, opaque(256)}; XSched S{xg, lb, nlb, 4}; Epi8b E{P};
      pg8::gemm_phase<Epi8b, XSched, false, true>(lds, g, S, E); } }
}

extern "C" void kernel_launch(void* const* d_in, const int* in_sizes, int n_in, void* d_out, int out_size, void* d_ws, size_t ws_size, hipStream_t stream) {
    if (ws_size < WS_NEED) { fprintf(stderr, "workspace too small: %zu < %zu\n", ws_size, (size_t)WS_NEED); return; }
    Params P{};
    const float** f = (const float**)&P;
    for (int i = 0; i < 21; ++i) f[i] = (const float*)d_in[i];
    P.out = (float*)d_out; P.ws = (unsigned char*)d_ws;
    static int grid_blocks = 0;
    if (!grid_blocks) {
        int dev = 0, cus = 0, per_cu = 0;
        hipGetDevice(&dev);
        hipDeviceGetAttribute(&cus, hipDeviceAttributeMultiprocessorCount, dev);
        hipFuncSetAttribute((const void*)k_mega, hipFuncAttributeMaxDynamicSharedMemorySize, LDS_BYTES);
        hipOccupancyMaxActiveBlocksPerMultiprocessor(&per_cu, k_mega, NTHR, LDS_BYTES);
        if (per_cu < 1) { fprintf(stderr, "occupancy query says %d blocks per CU\n", per_cu); per_cu = 1; }
        grid_blocks = cus;
        if (grid_blocks != 256) { fprintf(stderr, "this kernel is built for a 256-CU device (got %d CUs); launching 256 workgroups\n", cus); grid_blocks = 256; }
    }
    hipMemsetAsync(d_ws, 0, 32768, stream);
    void* args[] = {&P};
    hipError_t e = hipLaunchCooperativeKernel((void*)k_mega, dim3(grid_blocks), dim3(NTHR), args, LDS_BYTES, stream);
    if (e != hipSuccess) fprintf(stderr, "cooperative launch failed: %s (grid %d)\n", hipGetErrorString(e), grid_blocks);
}
```

```cpp
#include <hip/hip_runtime.h>
#include <stdint.h>
#include <cstdio>
#ifndef PHMASK
#define PHMASK 0xFFFF
#endif
#define PH(n) ((PHMASK >> (n)) & 1)
#define REP_P0 1
#define REP_P1 1
#define REP_P2 1
#define REP_P3 1
#define REP_P4 1
#define REP_P5 1
#define REP_P6 1
#define REP_P7 1
#define REP_P8 1
#ifndef ATT_THR
#define ATT_PMAX 256.0f
#endif

typedef unsigned short bf16_t;
typedef short bf16x8 __attribute__((ext_vector_type(8)));
typedef float f32x4 __attribute__((ext_vector_type(4)));
typedef unsigned u32x4 __attribute__((ext_vector_type(4)));
typedef unsigned u32x2 __attribute__((ext_vector_type(2)));
#define LAS __attribute__((address_space(3)))

constexpr int T_ = 16384, S_ = 2048, NB_ = 8, D_ = 1024;
constexpr int NIN = 2304;
constexpr int C_QD = 0, C_KD = 512, C_VD = 1024, C_CQ = 1536, C_CKV = 1920, C_KR = 2176, C_END = 2208;
constexpr float EPS_ = 1e-6f;
constexpr float LOG2E = 1.4426950408889634f;
constexpr float QS_MLA = 0.10206207261596577f * LOG2E;
constexpr float QS_DIL = 0.125f * LOG2E;
constexpr int NTHR = 512, NWAVE = 8;
constexpr int LDS_RING = 131072, LDS_TOPK = 256 * 132 * 4, LDS_CTL = LDS_TOPK, LDS_KEYS = LDS_CTL + 64, LDS_BYTES = LDS_KEYS + 128 * 144;

constexpr size_t MiB = 1ull << 20;
constexpr size_t O_BAR   = 0;
constexpr size_t O_WIN   = 1 * MiB;
constexpr size_t O_WUQ   = 6 * MiB;
constexpr size_t O_WUKV  = 7 * MiB;
constexpr size_t O_WOUT  = 8 * MiB;
constexpr size_t O_WPQ   = 10 * MiB;
constexpr size_t O_WPG   = 12 * MiB;
constexpr size_t O_WPP   = 14 * MiB;
constexpr size_t O_K1B   = 14 * MiB + 512 * 1024;
constexpr size_t O_K2B   = O_K1B + 16384;
constexpr size_t O_COSM  = 15 * MiB;
constexpr size_t O_SINM  = O_COSM + 131072;
constexpr size_t O_COSD  = O_SINM + 131072;
constexpr size_t O_SIND  = O_COSD + 65536;
constexpr size_t O_RSTDX = O_SIND + 65536;
constexpr size_t O_RSTDQ = O_RSTDX + 65536;
constexpr size_t O_RSTDKV= O_RSTDX + 131072;
constexpr size_t O_RSTDH = O_RSTDX + 196608;
constexpr size_t O_RSTD2 = O_RSTDX + 262144;
constexpr size_t O_SSQQ  = 16 * MiB;
constexpr size_t O_SSQKV = 16 * MiB + 768 * 1024;
constexpr size_t O_SSMLA = 17 * MiB + 256 * 1024;
constexpr size_t O_SSQ3  = 16 * MiB;
constexpr size_t O_LSE   = 18 * MiB;
constexpr size_t O_SSQ2  = 19 * MiB + 512 * 1024;
constexpr size_t O_SSQH  = 20 * MiB;
constexpr size_t O_US    = 22 * MiB;
constexpr size_t O_VS    = O_US + 65536;
constexpr size_t O_PB    = 23 * MiB;
constexpr size_t O_D     = 31 * MiB;
constexpr size_t O_XB    = O_D;
constexpr size_t O_MIXED = O_D;
constexpr size_t O_GT    = O_D;
constexpr size_t O_CQ    = O_D + 32 * MiB;
constexpr size_t O_CKV   = O_D + 44 * MiB;
constexpr size_t O_QD    = O_D + 52 * MiB;
constexpr size_t O_KD    = O_D + 68 * MiB;
constexpr size_t O_VD    = O_D + 84 * MiB;
constexpr size_t O_QM    = O_D + 132 * MiB;
constexpr size_t O_KM    = O_D + 156 * MiB;
constexpr size_t O_VM    = O_D + 180 * MiB;
constexpr size_t O_HG    = O_D + 52 * MiB;
constexpr size_t O_UQ    = O_D + 100 * MiB;
constexpr size_t O_XQ    = O_D + 116 * MiB;
constexpr size_t O_VQ    = O_D + 196 * MiB;
constexpr size_t O_EIDX  = O_D + 212 * MiB;
constexpr size_t O_GATE  = O_D + 216 * MiB;
constexpr size_t WS_NEED = 256 * MiB;

struct Params {
    const float *x, *p, *g_mix, *w_in, *g_cq, *w_uq, *g_ckv, *w_ukv, *g_out_mla, *g_out_dil, *w_out, *g_ffn, *w_peer_q,
        *keys1, *keys2, *peer_u, *peer_v, *g_ple, *w_ple_gate, *w_ple_proj, *g_final;
    float* out;
    unsigned char* ws;
};

__device__ __forceinline__ bf16_t f2bf(float f) { unsigned u = __float_as_uint(f); u += 0x7fffu + ((u >> 16) & 1u); return (bf16_t)(u >> 16); }
__device__ __forceinline__ float bf2f(bf16_t b) { return __uint_as_float(((unsigned)b) << 16); }
typedef __bf16 bf16x2_t __attribute__((ext_vector_type(2)));
typedef float f32x2_t __attribute__((ext_vector_type(2)));
__device__ __forceinline__ unsigned pack2(float a, float b) { const f32x2_t v = {a, b}; const bf16x2_t r = __builtin_convertvector(v, bf16x2_t); return __builtin_bit_cast(unsigned, r); }
__device__ __forceinline__ float fexp2(float x) { return __builtin_amdgcn_exp2f(x); }
__device__ __forceinline__ float bflo(unsigned w) { return __uint_as_float(w << 16); }
__device__ __forceinline__ float bfhi(unsigned w) { return __uint_as_float(w & 0xffff0000u); }
#define DPP_I(v, ctrl) __builtin_amdgcn_update_dpp(0, (int)(v), (ctrl), 0xf, 0xf, true)
#define DPP_F(v, ctrl) __builtin_bit_cast(float, __builtin_amdgcn_update_dpp(0, __builtin_bit_cast(int, (float)(v)), (ctrl), 0xf, 0xf, true))
__device__ __forceinline__ float wave_sum(float v) {
    v += DPP_F(v, 0xB1); v += DPP_F(v, 0x4E); v += DPP_F(v, 0x141); v += DPP_F(v, 0x140);
    v += __shfl_xor(v, 16); v += __shfl_xor(v, 32);
    return v;
}
__device__ __forceinline__ float quad_sum(float v) { v += __shfl_xor(v, 16); v += __shfl_xor(v, 32); return v; }
__device__ __forceinline__ u32x2 pack4(f32x4 v) { return (u32x2){pack2(v[0], v[1]), pack2(v[2], v[3])}; }
template <typename Tp> __host__ __device__ __forceinline__ Tp* wsp(const Params& P, size_t off) { return (Tp*)(P.ws + off); }
__device__ __forceinline__ int dil_of(int p) { return p == 0 ? 1 : (p == 1 ? 4 : 16); }
__device__ __forceinline__ int respos(int s, int dil) { return (s % dil) * (S_ / dil) + s / dil; }
__device__ __forceinline__ float rstd_from(const float* part, int n, float invdim) { float s = 0.f; for (int i = 0; i < n; ++i) s += part[i]; return rsqrtf(s * invdim + EPS_); }
#define MFMA16(a, b, c) __builtin_amdgcn_mfma_f32_16x16x32_bf16((a), (b), (c), 0, 0, 0)

__device__ __forceinline__ int win_src_col(int n) {
    if (n < 512) return 672 + n;
    if (n < 1024) return 1184 + (n - 512);
    if (n < 1536) return 1696 + (n - 1024);
    if (n < 1920) return n - 1536;
    if (n < 2176) return 384 + (n - 1920);
    if (n < 2208) return 640 + (n - 2176);
    return -1;
}
__device__ __forceinline__ void wt_job(const float* __restrict__ W, int Nsrc, int K, int srccol, const float* __restrict__ g0, const float* __restrict__ g1, int gsplit,
                                       bf16_t* __restrict__ Wt, int n, int k0) {
    unsigned w[4];
#pragma unroll
    for (int j = 0; j < 4; ++j) {
        float a = 0.f, b = 0.f;
        if (srccol >= 0) {
            const int ka = k0 + 2 * j, kb = ka + 1;
            a = W[(size_t)ka * Nsrc + srccol]; b = W[(size_t)kb * Nsrc + srccol];
            if (g0) { a *= (ka < gsplit ? g0[ka] : g1[ka - gsplit]); b *= (kb < gsplit ? g0[kb] : g1[kb - gsplit]); }
        }
        w[j] = pack2(a, b);
    }
    *(u32x4*)(Wt + (size_t)n * K + k0) = (u32x4){w[0], w[1], w[2], w[3]};
}

__device__ __forceinline__ void prep_weights(const Params& P, long gtid, long gthreads) {
    for (long i = gtid; i < (long)NIN * 128; i += gthreads) { const int n = (int)(i % NIN), kc = (int)(i / NIN);
        wt_job(P.w_in, 2208, 1024, win_src_col(n), P.g_mix, P.g_mix, 1 << 30, wsp<bf16_t>(P, O_WIN), n, kc * 8); }
    for (long i = gtid; i < 2048L * 16; i += gthreads) { const int s = (int)(i >> 4), j = (int)(i & 15);
        const float inv = powf(500000.0f, -(float)(2 * j) / 32.0f); const float ang = (float)s * inv; float sn, cs; sincosf(ang, &sn, &cs);
        wsp<float>(P, O_COSM)[i] = cs; wsp<float>(P, O_SINM)[i] = sn; }
    for (long i = gtid; i < 2048L * 8; i += gthreads) { const int s = (int)(i >> 3), j = (int)(i & 7);
        const float inv = powf(500000.0f, -(float)(2 * j) / 16.0f); const float ang = (float)s * inv; float sn, cs; sincosf(ang, &sn, &cs);
        wsp<float>(P, O_COSD)[i] = cs; wsp<float>(P, O_SIND)[i] = sn; }
}
__device__ __forceinline__ void prep_weights_late(const Params& P, long gtid, long gthreads) {
    for (long i = gtid; i < 768L * 48; i += gthreads) { const int n = (int)(i % 768), kc = (int)(i / 768);
        wt_job(P.w_uq, 768, 384, n, P.g_cq, P.g_cq, 1 << 30, wsp<bf16_t>(P, O_WUQ), n, kc * 8); }
    for (long i = gtid; i < 1024L * 32; i += gthreads) { const int n = (int)(i % 1024), kc = (int)(i / 1024);
        wt_job(P.w_ukv, 1024, 256, n, P.g_ckv, P.g_ckv, 1 << 30, wsp<bf16_t>(P, O_WUKV), n, kc * 8); }
    for (long i = gtid; i < 1024L * 128; i += gthreads) { const int n = (int)(i % 1024), kc = (int)(i / 1024);
        wt_job(P.w_out, 1024, 1024, n, P.g_out_mla, P.g_out_dil, 512, wsp<bf16_t>(P, O_WOUT), n, kc * 8);
        wt_job(P.w_peer_q, 1024, 1024, n, P.g_ffn, P.g_ffn, 1 << 30, wsp<bf16_t>(P, O_WPQ), n, kc * 8);
        wt_job(P.w_ple_gate, 1024, 1024, n, P.g_ple, P.g_ple, 1 << 30, wsp<bf16_t>(P, O_WPG), n, kc * 8); }
    for (long i = gtid; i < 1024L * 32; i += gthreads) { const int n = (int)(i % 1024), kc = (int)(i / 1024);
        wt_job(P.w_ple_proj, 1024, 256, n, nullptr, nullptr, 0, wsp<bf16_t>(P, O_WPP), n, kc * 8); }
    for (long i = gtid; i < 128L * 64; i += gthreads) { wsp<bf16_t>(P, O_K1B)[i] = f2bf(P.keys1[i]); wsp<bf16_t>(P, O_K2B)[i] = f2bf(P.keys2[i]); }
}
__device__ __forceinline__ void prep_rows(const Params& P, long gwave, long gwaves, int lane, long tend = T_, long tstride = 0) {
    if (tstride == 0) tstride = gwaves;
    for (long t = gwave; t < tend; t += tstride) {
        const float* xr = P.x + (size_t)t * D_;
        float ss = 0.f; f32x4 v[4];
#pragma unroll
        for (int i = 0; i < 4; ++i) { v[i] = *(const f32x4*)(xr + i * 256 + lane * 4); ss += v[i][0] * v[i][0] + v[i][1] * v[i][1] + v[i][2] * v[i][2] + v[i][3] * v[i][3]; }
        ss = wave_sum(ss);
        bf16_t* xb = wsp<bf16_t>(P, O_XB) + (size_t)t * D_;
#pragma unroll
        for (int i = 0; i < 4; ++i) *(u32x2*)(xb + i * 256 + lane * 4) = (u32x2){pack2(v[i][0], v[i][1]), pack2(v[i][2], v[i][3])};
        if (lane == 0) wsp<float>(P, O_RSTDX)[t] = rsqrtf(ss * (1.0f / D_) + EPS_);
        const f32x4 pv = *(const f32x4*)(P.p + (size_t)t * 256 + lane * 4);
        *(u32x2*)(wsp<bf16_t>(P, O_PB) + (size_t)t * 256 + lane * 4) = (u32x2){pack2(pv[0], pv[1]), pack2(pv[2], pv[3])};
    }
}

#define XB_TMO      128
#define XB_XCNT(j)  (256  + 64 * (j))
#define XB_XSUB(j)  (1280 + 64 * (j))
#define XB_XGEN(j)  (2304 + 64 * (j))
#define XB_TOP      3328
#define XB_TOPGEN   3392
#define XCD_BAR_WORDS 3456
#define XB_SPIN_CAP (1u << 20)
#define LAS __attribute__((address_space(3)))
__device__ __forceinline__ unsigned xb_ld(unsigned* p)              { return __hip_atomic_load(p, __ATOMIC_RELAXED, __HIP_MEMORY_SCOPE_AGENT); }
__device__ __forceinline__ unsigned xb_add(unsigned* p, unsigned v) { return __hip_atomic_fetch_add(p, v, __ATOMIC_RELAXED, __HIP_MEMORY_SCOPE_AGENT); }
__device__ __forceinline__ unsigned xb_xcc_id() { return (unsigned)__builtin_amdgcn_s_getreg((3 << 11) | 20) & 0xFu; }
#define XB_SPIN(cond, bar) do { unsigned _sp = 0; while (cond) { __builtin_amdgcn_s_sleep(1); \
    if ((++_sp & 255u) == 0u) { if (xb_ld(&(bar)[XB_TMO])) break; if (_sp > XB_SPIN_CAP) { atomicAdd(&(bar)[XB_TMO], 1u); break; } } } } while (0)
struct XcdBarrier { unsigned* bar; unsigned x; volatile LAS unsigned* st; };
__device__ __forceinline__ XcdBarrier xcd_barrier_post(unsigned* bar, volatile LAS unsigned* st) {
    XcdBarrier b; b.bar = bar; b.x = xb_xcc_id(); b.st = st;
    if (threadIdx.x == 0) (void)xb_add(&bar[XB_XCNT(b.x)], 1u);
    return b;
}
__device__ __forceinline__ void xcd_barrier_complete(unsigned* bar, unsigned x, unsigned& nloc, unsigned& nx) {
    const unsigned G = gridDim.x * gridDim.y * gridDim.z;
    unsigned sum, cnt, mine, sp = 0u;
    for (;;) {
        sum = 0u; cnt = 0u; mine = 0u;
#pragma unroll
        for (unsigned j = 0; j < 16; ++j) { const unsigned c = xb_ld(&bar[XB_XCNT(j)]); sum += c; cnt += (c > 0u) ? 1u : 0u; mine = (j == x) ? c : mine; }
        if (sum == G) break;
        __builtin_amdgcn_s_sleep(1);
        if ((++sp & 255u) == 0u) { if (xb_ld(&bar[XB_TMO])) break; if (sp > XB_SPIN_CAP) { atomicAdd(&bar[XB_TMO], 1u); break; } }
    }
    nloc = mine > 0u ? mine : 1u; nx = cnt > 0u ? cnt : 1u;
}
__device__ __forceinline__ void xcd_barrier(const XcdBarrier& b, unsigned& epoch) {
    asm volatile("s_waitcnt vmcnt(0)" ::: "memory");
    __syncthreads();
    ++epoch;
    if (threadIdx.x == 0) {
        unsigned* bar = b.bar;
        __builtin_amdgcn_s_waitcnt(0);
        unsigned nloc = b.st[0], nx = b.st[1];
        if (nloc == 0u) { xcd_barrier_complete(bar, b.x, nloc, nx); b.st[0] = nloc; b.st[1] = nx; }
        const unsigned old = xb_add(&bar[XB_XSUB(b.x)], 1u);
        if (old + 1u == epoch * nloc) {
            __builtin_amdgcn_fence(__ATOMIC_RELEASE, "agent");
            asm volatile("s_waitcnt vmcnt(0)" ::: "memory");
            const unsigned og = xb_add(&bar[XB_TOP], 1u);
            if (og + 1u == epoch * nx) __hip_atomic_store(&bar[XB_TOPGEN], epoch, __ATOMIC_RELAXED, __HIP_MEMORY_SCOPE_AGENT);
        }
        XB_SPIN(xb_ld(&bar[XB_TOPGEN]) < epoch, bar);
        __builtin_amdgcn_fence(__ATOMIC_ACQUIRE, "agent");
        asm volatile("s_waitcnt vmcnt(0)" ::: "memory");
    }
    __syncthreads();
}

namespace pg8 {
#define PG8_LAS __attribute__((address_space(3)))
typedef unsigned short bf16_t;
typedef short bf16x8 __attribute__((ext_vector_type(8)));
typedef float f32x4 __attribute__((ext_vector_type(4)));
typedef unsigned u32x4 __attribute__((ext_vector_type(4)));
constexpr int BM = 256, BK = 64, HALF = 128, HTB = HALF * BK * 2  , STAGE_BYTES = 8 * HTB, NXCD = 8, WGM = 8;

__host__ __device__ __forceinline__ int lds_byte(int r, int c) { const int st = (r >> 4) * 2 + (c >> 5), rr = r & 15, cc = c & 31, ob = rr * 64 + cc * 2; return st * 1024 + (ob ^ (((ob >> 9) & 1) << 5)); }
__host__ __device__ __forceinline__ void stage_rc(int b, int& R, int& C) { const int st = b / 1024, sb = b % 1024, swz = sb ^ (((sb >> 9) & 1) << 5); R = (st >> 1) * 16 + swz / 64; C = (st & 1) * 32 + (swz % 64) / 2; }
__host__ __device__ __forceinline__ int perm32(int rho) { const int n = rho >> 4, i = rho & 15; return 8 * (i >> 2) + 4 * n + (i & 3); }

struct Unit { int pm, pn; };
struct Gemm { const bf16_t* A; const bf16_t* Bt; int M, N, K; };
template <class Epi, class Sched, bool ALIGN_EPI = false, bool SP2 = false>
__device__ __forceinline__ void gemm_phase(PG8_LAS unsigned char* lds, const Gemm g, const Sched& S, const Epi& E) {
    int tid_ = threadIdx.x; asm volatile("" : "+v"(tid_));
    const int tid = tid_, wid = __builtin_amdgcn_readfirstlane(tid >> 6), lane = tid & 63, wr = wid >> 2, wc = wid & 3, fr = lane & 15, fq = lane >> 4;
    const int K = g.K, nt = K / BK;
    unsigned voffA[2], voffB[2];
#pragma unroll
    for (int i = 0; i < 2; ++i) { int R, C; stage_rc(tid * 16 + i * 8192, R, C); const int Rb = Epi::PERM ? ((R & ~31) + perm32(R & 31)) : R;
        voffA[i] = (unsigned)(R * K + C) * 2u; voffB[i] = (unsigned)(Rb * K + C) * 2u; }
    const size_t kstep = (size_t)(BK * 2);
    const size_t hstep = (size_t)HALF * K * 2;
    const size_t tstep = 2 * hstep;
    const unsigned ldsw = (unsigned)wid * 1024u;
    const int aoff = lds_byte(wr * 64 + fr, fq * 8), boff = lds_byte(wc * 32 + fr, fq * 8);
#define PG8_SA(b, h) (((b) * 2 + (h)) * HTB)
#define PG8_SB(b, h) ((4 + (b) * 2 + (h)) * HTB)
#define PG8_STAGE(bufoff, gbase, voff) do { _Pragma("unroll") for (int _i = 0; _i < 2; ++_i) \
        __builtin_amdgcn_global_load_lds((const unsigned*)((const char*)(gbase) + (voff)[_i]), (PG8_LAS unsigned*)(lds + (bufoff) + ldsw + _i * 8192), 16, 0, 0); } while (0)
#define PG8_LDA(dst, b, h) do { _Pragma("unroll") for (int m = 0; m < 4; ++m) _Pragma("unroll") for (int k = 0; k < 2; ++k) dst[m][k] = *(const PG8_LAS bf16x8*)(lds + PG8_SA(b, h) + aoff + m * 2048 + k * 1024); } while (0)
#define PG8_LDB(dst, b, h) do { _Pragma("unroll") for (int n = 0; n < 2; ++n) _Pragma("unroll") for (int k = 0; k < 2; ++k) dst[n][k] = *(const PG8_LAS bf16x8*)(lds + PG8_SB(b, h) + boff + n * 2048 + k * 1024); } while (0)
#define PG8_MMA(ai, bj, At, Bt) do { __builtin_amdgcn_s_setprio(1); _Pragma("unroll") for (int m = 0; m < 4; ++m) _Pragma("unroll") for (int n = 0; n < 2; ++n) _Pragma("unroll") for (int k = 0; k < 2; ++k) \
        acc[ai][bj][m][n] = __builtin_amdgcn_mfma_f32_16x16x32_bf16(Bt[n][k], At[m][k], acc[ai][bj][m][n], 0, 0, 0); __builtin_amdgcn_s_setprio(0); } while (0)
#define PG8_WAIT_V(n) asm volatile("s_waitcnt vmcnt(" #n ")" ::: "memory")
#define PG8_WAIT_L(n) asm volatile("s_waitcnt lgkmcnt(" #n ")" ::: "memory")
#define PG8_BAR __builtin_amdgcn_s_barrier()
#define PG8_SCHED __builtin_amdgcn_sched_barrier(0)
    Unit cur, nxt; int ui = 0;
    if (!S.next(0, cur)) return;
    f32x4 acc[2][2][4][2];
#pragma unroll
    for (int a = 0; a < 2; ++a)
#pragma unroll
        for (int b = 0; b < 2; ++b)
#pragma unroll
            for (int m = 0; m < 4; ++m)
#pragma unroll
                for (int n = 0; n < 2; ++n) acc[a][b][m][n] = (f32x4){0.f, 0.f, 0.f, 0.f};
    bf16x8 At[4][2], B0[2][2], B1[2][2];
    const char* cA = (const char*)g.A + (size_t)cur.pm * tstep; const char* cB = (const char*)g.Bt + (size_t)cur.pn * tstep;
    S.a_ready(cur);
    if constexpr (SP2) {
        PG8_STAGE(PG8_SB(0, 0), cB, voffB); PG8_STAGE(PG8_SB(0, 1), cB + hstep, voffB); PG8_STAGE(PG8_SA(0, 0), cA, voffA); PG8_STAGE(PG8_SA(0, 1), cA + hstep, voffA);
        if (wr == 1) PG8_BAR;
        PG8_WAIT_V(2); PG8_BAR;
        PG8_STAGE(PG8_SB(1, 0), cB + kstep, voffB); PG8_STAGE(PG8_SA(1, 0), cA + kstep, voffA); PG8_STAGE(PG8_SB(1, 1), cB + hstep + kstep, voffB);
        PG8_WAIT_V(6); PG8_BAR;
    } else {
        PG8_STAGE(PG8_SB(0, 0), cB, voffB); PG8_STAGE(PG8_SA(0, 0), cA, voffA); PG8_STAGE(PG8_SB(0, 1), cB + hstep, voffB); PG8_STAGE(PG8_SA(0, 1), cA + hstep, voffA);
        if (wr == 1) PG8_BAR;
        PG8_WAIT_V(4); PG8_BAR;
        PG8_STAGE(PG8_SB(1, 0), cB + kstep, voffB); PG8_STAGE(PG8_SA(1, 0), cA + kstep, voffA); PG8_STAGE(PG8_SB(1, 1), cB + hstep + kstep, voffB);
        PG8_WAIT_V(6); PG8_BAR;
    }
    for (;;) {
        const bool has_next = S.next(ui + 1, nxt);
        const char* nA = has_next ? (const char*)g.A + (size_t)nxt.pm * tstep : cA; const char* nB = has_next ? (const char*)g.Bt + (size_t)nxt.pn * tstep : cB;
        for (int t = 0; t < nt; t += 2) {
            const bool last = (t == nt - 2);
            const char* a1 = cA + (size_t)(t + 1) * kstep;
            const char* a2 = last ? nA : cA + (size_t)(t + 2) * kstep; const char* b2 = last ? nB : cB + (size_t)(t + 2) * kstep;
            const char* a3 = a2 + kstep; const char* b3 = b2 + kstep;
            if (last && has_next) S.a_ready(nxt);
            if constexpr (SP2) {
            PG8_LDB(B0, 0, 0); PG8_LDB(B1, 0, 1); PG8_SCHED; PG8_LDA(At, 0, 0); PG8_STAGE(PG8_SA(1, 1), a1 + hstep, voffA);
            PG8_WAIT_V(8); PG8_WAIT_L(0); PG8_BAR; PG8_MMA(0, 0, At, B0); PG8_MMA(0, 1, At, B1); PG8_BAR; PG8_SCHED;
            PG8_LDA(At, 0, 1); PG8_STAGE(PG8_SB(0, 0), b2, voffB); PG8_STAGE(PG8_SB(0, 1), b2 + hstep, voffB); PG8_STAGE(PG8_SA(0, 0), a2, voffA);
            PG8_WAIT_V(8); PG8_WAIT_L(0); PG8_BAR; PG8_MMA(1, 0, At, B0); PG8_MMA(1, 1, At, B1); PG8_BAR; PG8_SCHED;
            PG8_LDB(B0, 1, 0); PG8_LDB(B1, 1, 1); PG8_SCHED; PG8_LDA(At, 1, 0); PG8_STAGE(PG8_SA(0, 1), a2 + hstep, voffA);
            PG8_WAIT_V(8); PG8_WAIT_L(0); PG8_BAR; PG8_MMA(0, 0, At, B0); PG8_MMA(0, 1, At, B1); PG8_BAR; PG8_SCHED;
            PG8_LDA(At, 1, 1); PG8_STAGE(PG8_SB(1, 0), b3, voffB); PG8_STAGE(PG8_SB(1, 1), b3 + hstep, voffB); PG8_STAGE(PG8_SA(1, 0), a3, voffA);
            PG8_WAIT_V(8); PG8_WAIT_L(0); PG8_BAR; PG8_MMA(1, 0, At, B0); PG8_MMA(1, 1, At, B1); PG8_BAR; PG8_SCHED;
            } else {
            PG8_LDB(B0, 0, 0); PG8_SCHED; PG8_LDA(At, 0, 0); PG8_STAGE(PG8_SA(1, 1), a1 + hstep, voffA);
            PG8_WAIT_L(8); PG8_BAR; PG8_WAIT_L(0); PG8_MMA(0, 0, At, B0); PG8_BAR; PG8_SCHED;
            PG8_LDB(B1, 0, 1); PG8_STAGE(PG8_SB(0, 0), b2, voffB);
            PG8_BAR; PG8_WAIT_L(0); PG8_MMA(0, 1, At, B1); PG8_BAR;
            PG8_LDA(At, 0, 1); PG8_STAGE(PG8_SA(0, 0), a2, voffA);
            PG8_BAR; PG8_WAIT_L(0); PG8_MMA(1, 0, At, B0); PG8_BAR; PG8_SCHED;
            PG8_STAGE(PG8_SB(0, 1), b2 + hstep, voffB);
            PG8_WAIT_V(6); PG8_BAR; PG8_MMA(1, 1, At, B1); PG8_BAR;
            PG8_LDB(B0, 1, 0); PG8_SCHED; PG8_LDA(At, 1, 0); PG8_STAGE(PG8_SA(0, 1), a2 + hstep, voffA);
            PG8_WAIT_L(8); PG8_BAR; PG8_WAIT_L(0); PG8_MMA(0, 0, At, B0); PG8_BAR; PG8_SCHED;
            PG8_LDB(B1, 1, 1); PG8_STAGE(PG8_SB(1, 0), b3, voffB);
            PG8_BAR; PG8_WAIT_L(0); PG8_MMA(0, 1, At, B1); PG8_BAR;
            PG8_LDA(At, 1, 1); PG8_STAGE(PG8_SA(1, 0), a3, voffA);
            PG8_BAR; PG8_WAIT_L(0); PG8_MMA(1, 0, At, B0); PG8_BAR; PG8_SCHED;
            PG8_STAGE(PG8_SB(1, 1), b3 + hstep, voffB);
            PG8_WAIT_V(6); PG8_BAR; PG8_MMA(1, 1, At, B1); PG8_BAR;
            }
        }
        if constexpr (ALIGN_EPI) { if (wr == 0) PG8_BAR; }
        if constexpr (!Epi::AFTER_DRAIN) { E(acc, cur, wr, wc, fr, fq); S.done(cur); }
        if (!has_next) break;
#pragma unroll
        for (int a = 0; a < 2; ++a)
#pragma unroll
            for (int b = 0; b < 2; ++b)
#pragma unroll
                for (int m = 0; m < 4; ++m)
#pragma unroll
                    for (int n = 0; n < 2; ++n) acc[a][b][m][n] = (f32x4){0.f, 0.f, 0.f, 0.f};
        cur = nxt; cA = nA; cB = nB; ++ui;
        if constexpr (ALIGN_EPI) { if (wr == 1) PG8_BAR; }
    }
    PG8_WAIT_V(0);
    if constexpr (!ALIGN_EPI) { if (wr == 0) PG8_BAR; }
    PG8_BAR;
    if constexpr (Epi::AFTER_DRAIN) { E.fused(acc, cur, wr, wc, fr, fq, lds, wid, lane); S.done(cur); }
#undef PG8_SA
#undef PG8_SB
#undef PG8_STAGE
#undef PG8_LDA
#undef PG8_LDB
#undef PG8_MMA
#undef PG8_WAIT_V
#undef PG8_WAIT_L
#undef PG8_BAR
#undef PG8_SCHED
}
}

__device__ __forceinline__ void rows_rstd(const float* part, int npart, float invdim, float* out, int pm, int t256) {
    const int t = pm * 256 + t256; float s = 0.f;
    for (int i = 0; i < npart; ++i) s += part[(size_t)t * npart + i];
    out[t] = rsqrtf(s * invdim + EPS_);
}
__device__ __forceinline__ int opaque(int v) { asm volatile("" : "+s"(v)); return v; }
__device__ __forceinline__ int opq_v(int v) { asm volatile("" : "+v"(v)); return v; }
#define WG_PUBLISH() do { asm volatile("s_waitcnt vmcnt(0)" ::: "memory"); __builtin_amdgcn_fence(__ATOMIC_RELEASE, "workgroup"); __syncthreads(); __builtin_amdgcn_fence(__ATOMIC_ACQUIRE, "workgroup"); } while (0)
struct XSched {
    int xg, lb, nlb, npn;
    __device__ __forceinline__ bool next(int i, pg8::Unit& u) const { const int j = lb + i * nlb; if (j >= 8 * npn) return false; u.pm = xg * 8 + (j & 7); u.pn = j >> 3; return true; }
    __device__ __forceinline__ void a_ready(const pg8::Unit&) const {}
    __device__ __forceinline__ void done(const pg8::Unit&) const {}
};
typedef f32x4 Acc8[2][2][4][2];

struct Epi1 {
    static constexpr bool PERM = false, AFTER_DRAIN = false; Params P;
    __device__ __forceinline__ void operator()(const Acc8& acc, const pg8::Unit& u, int wr, int wc, int fr, int fq) const {
#pragma unroll
        for (int bj = 0; bj < 2; ++bj) {
            const int cg = u.pn * 256 + bj * 128 + wc * 32;
            if (cg >= C_KR + 32) continue;
#pragma unroll
            for (int ai = 0; ai < 2; ++ai)
#pragma unroll
                for (int m = 0; m < 4; ++m) {
                    const int t = u.pm * 256 + ai * 128 + wr * 64 + m * 16 + fr, b = t >> 11, s = t & 2047;
                    const float rs = wsp<float>(P, O_RSTDX)[t];
                    if (cg < C_VD) {
                        const bool isq = cg < C_KD; const int cc = isq ? cg : cg - C_KD, h = cc >> 6, d0 = cc & 63;
                        bf16_t* dst = wsp<bf16_t>(P, isq ? O_QD : O_KD) + (((size_t)b * 8 + h) * S_ + s) * 64 + d0;
#pragma unroll
                        for (int n = 0; n < 2; ++n) {
                            f32x4 v = acc[ai][bj][m][n] * rs;
                            if (d0 == 0 && n == 0) {
#pragma unroll
                                for (int r = 0; r < 4; ++r) { const float pv = __shfl_xor(v[r], 32); const int j = (4 * fq + r) & 7;
                                    const float cs = wsp<float>(P, O_COSD)[s * 8 + j], sn = wsp<float>(P, O_SIND)[s * 8 + j];
                                    v[r] = fq < 2 ? v[r] * cs - pv * sn : v[r] * cs + pv * sn; }
                            }
                            if (isq) v = v * QS_DIL;
                            *(u32x2*)(dst + n * 16 + 4 * fq) = pack4(v);
                        }
                    } else if (cg < C_CQ) {
                        const int h = (cg - C_VD) >> 6, d0 = (cg - C_VD) & 63;
                        bf16_t* dst = wsp<bf16_t>(P, O_VD) + (((size_t)b * 8 + h) * S_ + s) * 64 + d0;
#pragma unroll
                        for (int n = 0; n < 2; ++n) *(u32x2*)(dst + n * 16 + 4 * fq) = pack4(acc[ai][bj][m][n] * rs);
                    } else if (cg < C_KR) {
                        const bool isq = cg < C_CKV; const int c0 = isq ? cg - C_CQ : cg - C_CKV;
                        bf16_t* dst = isq ? wsp<bf16_t>(P, O_CQ) + (size_t)t * 384 + c0 : wsp<bf16_t>(P, O_CKV) + (size_t)t * 256 + c0;
                        float ss = 0.f;
#pragma unroll
                        for (int n = 0; n < 2; ++n) { const f32x4 v = acc[ai][bj][m][n] * rs; ss += v[0] * v[0] + v[1] * v[1] + v[2] * v[2] + v[3] * v[3]; *(u32x2*)(dst + n * 16 + 4 * fq) = pack4(v); }
                        ss = quad_sum(ss);
                        if (fq == 0) { if (isq) wsp<float>(P, O_SSQQ)[(size_t)t * 12 + (c0 >> 5)] = ss; else wsp<float>(P, O_SSQKV)[(size_t)t * 8 + (c0 >> 5)] = ss; }
                    } else {
                        const f32x4 x1 = acc[ai][bj][m][0] * rs, x2 = acc[ai][bj][m][1] * rs; f32x4 o1, o2;
#pragma unroll
                        for (int r = 0; r < 4; ++r) { const int j = 4 * fq + r; const float cs = wsp<float>(P, O_COSM)[s * 16 + j], sn = wsp<float>(P, O_SINM)[s * 16 + j];
                            o1[r] = x1[r] * cs - x2[r] * sn; o2[r] = x2[r] * cs + x1[r] * sn; }
                        const u32x2 w1 = pack4(o1), w2 = pack4(o2);
#pragma unroll
                        for (int h = 0; h < 8; ++h) { bf16_t* dst = wsp<bf16_t>(P, O_KM) + (((size_t)b * 8 + h) * S_ + s) * 96 + 64 + 4 * fq; *(u32x2*)dst = w1; *(u32x2*)(dst + 16) = w2; }
                    }
                    asm volatile("" ::: "memory");
                }
        }
    }
};
struct Epi2a {
    static constexpr bool PERM = false, AFTER_DRAIN = false; Params P;
    __device__ __forceinline__ void operator()(const Acc8& acc, const pg8::Unit& u, int wr, int wc, int fr, int fq) const {
#pragma unroll
        for (int ai = 0; ai < 2; ++ai)
#pragma unroll
            for (int m = 0; m < 4; ++m) {
                const int t = u.pm * 256 + ai * 128 + wr * 64 + m * 16 + fr, b = t >> 11, s = t & 2047;
                const float rs = wsp<float>(P, O_RSTDQ)[t] * QS_MLA;
#pragma unroll
                for (int bj = 0; bj < 2; ++bj) {
                    const int cg = u.pn * 256 + bj * 128 + wc * 32, hq = cg / 96, d0 = cg - hq * 96;
                    bf16_t* dst = wsp<bf16_t>(P, O_QM) + (((size_t)b * 8 + hq) * S_ + s) * 96;
                    if (d0 < 64) {
#pragma unroll
                        for (int n = 0; n < 2; ++n) *(u32x2*)(dst + d0 + n * 16 + 4 * fq) = pack4(acc[ai][bj][m][n] * rs);
                    } else {
                        const f32x4 x1 = acc[ai][bj][m][0] * rs, x2 = acc[ai][bj][m][1] * rs; f32x4 o1, o2;
#pragma unroll
                        for (int r = 0; r < 4; ++r) { const int j = 4 * fq + r; const float cs = wsp<float>(P, O_COSM)[s * 16 + j], sn = wsp<float>(P, O_SINM)[s * 16 + j];
                            o1[r] = x1[r] * cs - x2[r] * sn; o2[r] = x2[r] * cs + x1[r] * sn; }
                        *(u32x2*)(dst + 64 + 4 * fq) = pack4(o1); *(u32x2*)(dst + 80 + 4 * fq) = pack4(o2);
                    }
                }
                asm volatile("" ::: "memory");
            }
    }
};
struct Epi2b {
    static constexpr bool PERM = false, AFTER_DRAIN = false; Params P;
    __device__ __forceinline__ void operator()(const Acc8& acc, const pg8::Unit& u, int wr, int wc, int fr, int fq) const {
#pragma unroll
        for (int ai = 0; ai < 2; ++ai)
#pragma unroll
            for (int m = 0; m < 4; ++m) {
                const int t = u.pm * 256 + ai * 128 + wr * 64 + m * 16 + fr, b = t >> 11, s = t & 2047;
                const float rs = wsp<float>(P, O_RSTDKV)[t];
#pragma unroll
                for (int bj = 0; bj < 2; ++bj) {
                    const int cg = u.pn * 256 + bj * 128 + wc * 32, h = cg >> 7, d0 = cg & 127;
#pragma unroll
                    for (int n = 0; n < 2; ++n) { const f32x4 v = acc[ai][bj][m][n] * rs;
                        if (d0 < 64) *(u32x2*)(wsp<bf16_t>(P, O_KM) + (((size_t)b * 8 + h) * S_ + s) * 96 + d0 + n * 16 + 4 * fq) = pack4(v);
                        else *(u32x2*)(wsp<bf16_t>(P, O_VM) + (((size_t)b * 8 + h) * S_ + s) * 64 + (d0 - 64) + n * 16 + 4 * fq) = pack4(v);
                    }
                }
            }
    }
};
struct Epi5 {
    static constexpr bool PERM = false, AFTER_DRAIN = false; Params P;
    __device__ __forceinline__ void operator()(const Acc8& acc, const pg8::Unit& u, int wr, int wc, int fr, int fq) const {
#pragma unroll
        for (int ai = 0; ai < 2; ++ai)
#pragma unroll
            for (int m = 0; m < 4; ++m) {
                const int t = u.pm * 256 + ai * 128 + wr * 64 + m * 16 + fr;
#pragma unroll
                for (int bj = 0; bj < 2; ++bj) { const int cg = u.pn * 256 + bj * 128 + wc * 32; float ss = 0.f;
#pragma unroll
                    for (int n = 0; n < 2; ++n) { const int c = cg + n * 16 + 4 * fq; const size_t o = (size_t)t * D_ + c;
                        const f32x4 v = acc[ai][bj][m][n] + *(const f32x4*)(P.x + o);
                        ss += v[0] * v[0] + v[1] * v[1] + v[2] * v[2] + v[3] * v[3];
                        *(u32x2*)(wsp<bf16_t>(P, O_HG) + o) = pack4(v); }
                    ss = quad_sum(ss);
                    if (fq == 0) wsp<float>(P, O_SSQH)[(size_t)t * 32 + (cg >> 5)] = ss; }
            }
    }
};
struct Epi8a {
    static constexpr bool PERM = false, AFTER_DRAIN = false; Params P;
    __device__ __forceinline__ void operator()(const Acc8& acc, const pg8::Unit& u, int wr, int wc, int fr, int fq) const {
#pragma unroll
        for (int ai = 0; ai < 2; ++ai)
#pragma unroll
            for (int m = 0; m < 4; ++m) {
                const int t = u.pm * 256 + ai * 128 + wr * 64 + m * 16 + fr;
                const float rs = wsp<float>(P, O_RSTD2)[t];
#pragma unroll
                for (int bj = 0; bj < 2; ++bj)
#pragma unroll
                    for (int n = 0; n < 2; ++n) { const int c = u.pn * 256 + bj * 128 + wc * 32 + n * 16 + 4 * fq; f32x4 g;
#pragma unroll
                        for (int r = 0; r < 4; ++r) g[r] = 1.0f / (1.0f + __expf(-rs * acc[ai][bj][m][n][r]));
                        *(u32x2*)(wsp<bf16_t>(P, O_GT) + (size_t)t * D_ + c) = pack4(g); }
            }
    }
};
constexpr int PANEL_CNT0 = 4096;
struct Epi8b {
    static constexpr bool PERM = false, AFTER_DRAIN = true; Params P;
    __device__ __forceinline__ void operator()(const Acc8&, const pg8::Unit&, int, int, int, int) const {}
    __device__ __forceinline__ void fused(Acc8& acc, const pg8::Unit& u, int wr, int wc, int fr, int fq, LAS unsigned char* lds, int wid, int lane) const {
        const int tid = wid * 64 + lane;
#pragma unroll
        for (int ai = 0; ai < 2; ++ai)
#pragma unroll
            for (int m = 0; m < 4; ++m) {
                const int t = u.pm * 256 + ai * 128 + wr * 64 + m * 16 + fr;
#pragma unroll
                for (int bj = 0; bj < 2; ++bj) { const int cg = u.pn * 256 + bj * 128 + wc * 32; float ss = 0.f;
#pragma unroll
                    for (int n = 0; n < 2; ++n) { const int c = cg + n * 16 + 4 * fq; const size_t o = (size_t)t * D_ + c;
                        const u32x2 hw = *(const u32x2*)(wsp<bf16_t>(P, O_HG) + o); f32x4 v = (f32x4){bflo(hw[0]), bfhi(hw[0]), bflo(hw[1]), bfhi(hw[1])}; const u32x2 gw = *(const u32x2*)(wsp<bf16_t>(P, O_GT) + o);
                        v[0] += bflo(gw[0]) * acc[ai][bj][m][n][0]; v[1] += bfhi(gw[0]) * acc[ai][bj][m][n][1]; v[2] += bflo(gw[1]) * acc[ai][bj][m][n][2]; v[3] += bfhi(gw[1]) * acc[ai][bj][m][n][3];
                        ss += v[0] * v[0] + v[1] * v[1] + v[2] * v[2] + v[3] * v[3];
                        acc[ai][bj][m][n] = v; }
                    ss = quad_sum(ss);
                    if (fq == 0) wsp<float>(P, O_SSQ3)[(size_t)t * 32 + (cg >> 5)] = ss; }
                asm volatile("" ::: "memory");
            }
        asm volatile("s_waitcnt vmcnt(0)" ::: "memory");
        __syncthreads();
        if (tid == 0) {
            unsigned* bar = (unsigned*)(P.ws + O_BAR); unsigned* cnt = bar + PANEL_CNT0 + 64 * u.pm;
            __builtin_amdgcn_fence(__ATOMIC_RELEASE, "agent");
            asm volatile("s_waitcnt vmcnt(0)" ::: "memory");
            (void)xb_add(cnt, 1u);
            XB_SPIN(xb_ld(cnt) < 4u, bar);
            __builtin_amdgcn_fence(__ATOMIC_ACQUIRE, "agent");
            asm volatile("s_waitcnt vmcnt(0)" ::: "memory");
        }
        __syncthreads();
        LAS float* rsl = (LAS float*)lds;
        if (tid < 256) { const int t = u.pm * 256 + tid; float sm = 0.f;
#pragma unroll
            for (int i = 0; i < 8; ++i) { const f32x4 pv = *(const f32x4*)(wsp<float>(P, O_SSQ3) + (size_t)t * 32 + 4 * i); sm += (pv[0] + pv[1]) + (pv[2] + pv[3]); }
            rsl[tid] = rsqrtf(sm * (1.0f / D_) + EPS_); }
        __syncthreads();
#pragma unroll
        for (int ai = 0; ai < 2; ++ai)
#pragma unroll
            for (int m = 0; m < 4; ++m) {
                const int row = ai * 128 + wr * 64 + m * 16 + fr; const float rs = rsl[row];
#pragma unroll
                for (int bj = 0; bj < 2; ++bj)
#pragma unroll
                    for (int n = 0; n < 2; ++n) { const int c = u.pn * 256 + bj * 128 + wc * 32 + n * 16 + 4 * fq; const f32x4 g = *(const f32x4*)(P.g_final + c);
                        f32x4 v = acc[ai][bj][m][n]; v[0] *= rs * g[0]; v[1] *= rs * g[1]; v[2] *= rs * g[2]; v[3] *= rs * g[3];
                        *(f32x4*)(P.out + (size_t)(u.pm * 256 + row) * D_ + c) = v; }
                asm volatile("" ::: "memory");
            }
    }
};
__device__ __forceinline__ unsigned f2key(float f) { const unsigned u = __float_as_uint(f); return u ^ ((unsigned)((int)u >> 31) | 0x80000000u); }
__device__ __forceinline__ float key2f(unsigned k) { return __uint_as_float(k ^ (~(unsigned)((int)k >> 31) | 0x80000000u)); }
__device__ __forceinline__ unsigned umax_(unsigned a, unsigned b) { return a > b ? a : b; }
__device__ __forceinline__ unsigned umin_(unsigned a, unsigned b) { return a < b ? a : b; }
__device__ __forceinline__ void ins16(unsigned (&L)[16], unsigned x) {
#pragma unroll
    for (int j = 0; j < 16; ++j) { const unsigned hi = umax_(L[j], x); x = umin_(L[j], x); L[j] = hi; }
}
__device__ __forceinline__ void bitonic_desc16(unsigned (&c)[16]) {
#pragma unroll
    for (int st = 8; st >= 1; st >>= 1)
#pragma unroll
        for (int j = 0; j < 16; ++j) if ((j & st) == 0) { const unsigned hi = umax_(c[j], c[j + st]), lo = umin_(c[j], c[j + st]); c[j] = hi; c[j + st] = lo; }
}


constexpr int OE_N = 63;
constexpr int OE_I[OE_N] = {0,2,0,1,1,4,6,4,5,5,0,2,2,1,3,3,1,3,5,8,10,8,9,9,12,14,12,13,13,8,10,10,9,11,11,9,11,13,0,4,4,2,6,6,2,6,10,1,5,5,3,7,7,3,7,11,1,3,5,7,9,11,13};
constexpr int OE_J[OE_N] = {1,3,2,3,2,5,7,6,7,6,4,6,4,5,7,5,2,4,6,9,11,10,11,10,13,15,14,15,14,12,14,12,13,15,13,10,12,14,8,12,8,10,14,10,4,8,12,9,13,9,11,15,11,5,9,13,2,4,6,8,10,12,14};
__device__ __forceinline__ void sort_desc16(unsigned (&c)[16]) {
#pragma unroll
    for (int n = 0; n < OE_N; ++n) { const unsigned hi = umax_(c[OE_I[n]], c[OE_J[n]]), lo = umin_(c[OE_I[n]], c[OE_J[n]]); c[OE_I[n]] = hi; c[OE_J[n]] = lo; }
}
__device__ __forceinline__ void merge_desc16(unsigned (&a)[16], const unsigned (&b)[16]) {
#pragma unroll
    for (int j = 0; j < 16; ++j) a[j] = umax_(a[j], b[15 - j]);
    bitonic_desc16(a);
}
constexpr int CAND_N = 50;
constexpr int CAND_I[64] = {0,0,0,0,0,0,0,0,0,0,0,0,0,0,0,0,1,1,1,1,1,1,1,1,2,2,2,2,2,3,3,3,3,4,4,4,5,5,6,6,7,7,8,9,10,11,12,13,14,15,0,0,0,0,0,0,0,0,0,0,0,0,0,0};
constexpr int CAND_J[64] = {0,1,2,3,4,5,6,7,8,9,10,11,12,13,14,15,0,1,2,3,4,5,6,7,0,1,2,3,4,0,1,2,3,0,1,2,0,1,0,1,0,1,0,0,0,0,0,0,0,0,0,0,0,0,0,0,0,0,0,0,0,0,0,0};
struct Epi6q {
    static constexpr bool PERM = false, AFTER_DRAIN = false; Params P;
    __device__ __forceinline__ void operator()(const Acc8& acc, const pg8::Unit& u, int wr, int wc, int fr, int fq) const {
#pragma unroll
        for (int ai = 0; ai < 2; ++ai)
#pragma unroll
            for (int m = 0; m < 4; ++m) { const int t = u.pm * 256 + ai * 128 + wr * 64 + m * 16 + fr;
                const float rs = wsp<float>(P, O_RSTDH)[t];
#pragma unroll
                for (int bj = 0; bj < 2; ++bj)
#pragma unroll
                    for (int n = 0; n < 2; ++n) { const int c = u.pn * 256 + bj * 128 + wc * 32 + n * 16 + 4 * fq;
                        *(u32x2*)(wsp<bf16_t>(P, O_GT) + (size_t)t * D_ + c) = pack4(acc[ai][bj][m][n] * rs); }
                asm volatile("" ::: "memory"); }
    }
};
__device__ __forceinline__ void p6_topk(const Params& P, int pm, int pn, LAS unsigned char* lds, int tid) {
    const int lane = tid & 63, wid = tid >> 6, fr = lane & 15, fq = lane >> 4;
    LAS unsigned* sk = (LAS unsigned*)lds; const int row = tid >> 1, part = tid & 1;
    const bf16_t* QT = wsp<bf16_t>(P, O_GT) + (size_t)(pm * 256) * D_;
    LAS unsigned char* kl = lds + LDS_KEYS;
    const bf16_t* kg = wsp<bf16_t>(P, O_K1B) + (tid >> 2) * 64 + (tid & 3) * 16;
    LAS unsigned char* kd = kl + (tid >> 2) * 144 + (tid & 3) * 32;
    bf16x8 qfr[2][2];
    auto QLOAD = [&](int hd, int half_) {
#pragma unroll
        for (int ks = 0; ks < 2; ++ks)
#pragma unroll
            for (int tf = 0; tf < 2; ++tf) qfr[ks][tf] = *(const bf16x8*)(QT + (size_t)(32 * wid + 16 * tf + fr) * D_ + (pn * 2 + hd) * 128 + half_ * 64 + ks * 32 + fq * 8); };
    { const u32x4 k0 = *(const u32x4*)kg, k1 = *(const u32x4*)(kg + 8); QLOAD(0, 0); *(LAS u32x4*)kd = k0; *(LAS u32x4*)(kd + 16) = k1; }
    __syncthreads();
#pragma unroll 1
    for (int hh = 0; hh < 2; ++hh) {
        unsigned A[2][16];
#pragma unroll
        for (int half = 0; half < 2; ++half) {
            u32x4 kn0, kn1;
            {
                kn0 = *(const u32x4*)(kg + (half ^ 1) * 8192); kn1 = *(const u32x4*)(kg + (half ^ 1) * 8192 + 8);
                f32x4 sacc[8][2];
#pragma unroll
                for (int kf = 0; kf < 8; ++kf) { sacc[kf][0] = (f32x4){0.f, 0.f, 0.f, 0.f}; sacc[kf][1] = (f32x4){0.f, 0.f, 0.f, 0.f}; }
                bf16x8 kfr[2][8];
#pragma unroll
                for (int ks = 0; ks < 2; ++ks)
#pragma unroll
                    for (int kf = 0; kf < 8; ++kf) kfr[ks][kf] = *(const LAS bf16x8*)(kl + (kf * 16 + fr) * 144 + ks * 64 + fq * 16);
                __builtin_amdgcn_sched_barrier(0);
#pragma unroll
                for (int ks = 0; ks < 2; ++ks)
#pragma unroll
                    for (int kf = 0; kf < 8; ++kf) { sacc[kf][0] = MFMA16(kfr[ks][kf], qfr[ks][0], sacc[kf][0]); sacc[kf][1] = MFMA16(kfr[ks][kf], qfr[ks][1], sacc[kf][1]); }
                QLOAD(half ? (hh < 1 ? hh + 1 : 1) : hh, half ^ 1);
#pragma unroll
                for (int tf = 0; tf < 2; ++tf) { LAS unsigned* sp = sk + (32 * wid + 16 * tf + fr) * 132 + 4 * fq; const unsigned kl = (unsigned)(4 * fq);
#pragma unroll
                    for (int kf = 0; kf < 8; ++kf) { u32x4 w;
#pragma unroll
                        for (int r = 0; r < 4; ++r) w[r] = (f2key(sacc[kf][tf][r]) & ~127u) | (kl + (unsigned)(kf * 16 + r));
                        *(LAS u32x4*)(sp + kf * 16) = w; } }
            }
            __syncthreads();
            *(LAS u32x4*)kd = kn0; *(LAS u32x4*)(kd + 16) = kn1;
            unsigned kk[4][16];
#pragma unroll
            for (int gi = 0; gi < 4; ++gi)
#pragma unroll
                for (int c = 0; c < 4; ++c) { const u32x4 v = *(const LAS u32x4*)(sk + row * 132 + gi * 32 + part * 16 + 4 * c); kk[gi][4 * c] = v[0]; kk[gi][4 * c + 1] = v[1]; kk[gi][4 * c + 2] = v[2]; kk[gi][4 * c + 3] = v[3]; }
#pragma unroll
            for (int gi = 0; gi < 4; ++gi) sort_desc16(kk[gi]);
            merge_desc16(kk[0], kk[1]); merge_desc16(kk[2], kk[3]); merge_desc16(kk[0], kk[2]);
            unsigned c[16];
#pragma unroll
            for (int j = 0; j < 16; ++j) c[j] = umax_(kk[0][j], (unsigned)DPP_I(kk[0][15 - j], 0xB1));
            bitonic_desc16(c);
#pragma unroll
            for (int j = 0; j < 16; ++j) A[half][j] = c[j];
            __syncthreads();
        }
        float fa[16], fb[16];
#pragma unroll
        for (int j = 0; j < 16; ++j) { fa[j] = key2f(A[0][j] & ~127u); fb[j] = key2f(A[1][j] & ~127u); }
        unsigned x0[16], x1[16];
#pragma unroll
        for (int m = 0; m < 16; ++m) {
            const unsigned a0 = (m < CAND_N) ? ((f2key(fa[CAND_I[m]] + fb[CAND_J[m]]) & ~255u) | (unsigned)(CAND_I[m] * 16 + CAND_J[m])) : 0u;
            const unsigned a1 = (m + 16 < CAND_N) ? ((f2key(fa[CAND_I[m + 16]] + fb[CAND_J[m + 16]]) & ~255u) | (unsigned)(CAND_I[m + 16] * 16 + CAND_J[m + 16])) : 0u;
            const unsigned b0 = (m + 32 < CAND_N) ? ((f2key(fa[CAND_I[m + 32]] + fb[CAND_J[m + 32]]) & ~255u) | (unsigned)(CAND_I[m + 32] * 16 + CAND_J[m + 32])) : 0u;
            const unsigned b1 = (m + 48 < CAND_N) ? ((f2key(fa[CAND_I[m + 48]] + fb[CAND_J[m + 48]]) & ~255u) | (unsigned)(CAND_I[m + 48] * 16 + CAND_J[m + 48])) : 0u;
            x0[m] = part ? b0 : a0; x1[m] = part ? b1 : a1; }
        sort_desc16(x0); sort_desc16(x1); merge_desc16(x0, x1);
        unsigned C[16];
#pragma unroll
        for (int j = 0; j < 16; ++j) C[j] = umax_(x0[j], (unsigned)DPP_I(x0[15 - j], 0xB1));
        bitonic_desc16(C);
        if (part == 0) {
            const int t = pm * 256 + row, h = pn * 2 + hh; float ev[16]; float den = 0.f; const float top0 = key2f(C[0] & ~255u); unsigned eo[16];
            unsigned ia4[4], ib4[4];
#pragma unroll
            for (int q = 0; q < 4; ++q) {
                ia4[q] = (__builtin_amdgcn_perm(A[0][4 * q + 1], A[0][4 * q], 0x0c0c0400u) | __builtin_amdgcn_perm(A[0][4 * q + 3], A[0][4 * q + 2], 0x04000c0cu)) & 0x7f7f7f7fu;
                ib4[q] = (__builtin_amdgcn_perm(A[1][4 * q + 1], A[1][4 * q], 0x0c0c0400u) | __builtin_amdgcn_perm(A[1][4 * q + 3], A[1][4 * q + 2], 0x04000c0cu)) & 0x7f7f7f7fu; }
#pragma unroll
            for (int k = 0; k < 16; ++k) { const unsigned pos = C[k] & 255u, pi = pos >> 4, pj = pos & 15u;
                const unsigned la = __builtin_amdgcn_perm(ia4[1], ia4[0], pi & 7u), ha = __builtin_amdgcn_perm(ia4[3], ia4[2], pi & 7u);
                const unsigned lb_ = __builtin_amdgcn_perm(ib4[1], ib4[0], pj & 7u), hb = __builtin_amdgcn_perm(ib4[3], ib4[2], pj & 7u);
                const unsigned ia = ((pi & 8u) ? ha : la) & 255u, ib = ((pj & 8u) ? hb : lb_) & 255u;
                eo[k] = ia * 128u + ib; ev[k] = __expf(key2f(C[k] & ~255u) - top0); den += ev[k]; }
            const float id = 1.0f / den;
            unsigned short* ep = wsp<unsigned short>(P, O_EIDX) + (size_t)t * 128 + 2 * h; float* gp = wsp<float>(P, O_GATE) + (size_t)t * 128 + h * 16;
#pragma unroll
            for (int r = 0; r < 16; ++r) ep[(r & 7) * 16 + (r >> 3)] = (unsigned short)eo[r];
#pragma unroll
            for (int k = 0; k < 4; ++k) *(f32x4*)(gp + 4 * k) = (f32x4){ev[4 * k] * id, ev[4 * k + 1] * id, ev[4 * k + 2] * id, ev[4 * k + 3] * id};
        }
    }
}

typedef short v4i16_t __attribute__((ext_vector_type(4)));
__device__ __forceinline__ v4i16_t vtr(const LAS unsigned char* p) { return __builtin_amdgcn_ds_read_tr16_b64_v4i16((LAS v4i16_t*)p); }
template <int DQK, int NQB, bool BAND>
__device__ __forceinline__ void attn_item(const bf16_t* __restrict__ Qb, int qrs, const bf16_t* __restrict__ Kb, int krs, const bf16_t* __restrict__ Vb, int vrs,
                          int q0, int kt_begin, int kt_end, LAS unsigned char* smem, int tid,
                          bf16_t* __restrict__ Ob, int ors, float* __restrict__ statb, int srs) {
    constexpr int KS = DQK / 32, KP = DQK * 2 + 16, CPR = DQK / 8, KT = 128, NKC = KT * CPR, NKI = NKC / 512, VP = 160, STG = KT * KP + KT * VP;
    const int lane = tid & 63, w = tid >> 6, fr = lane & 15, fq = lane >> 4;
    bf16x8 qf[NQB][KS];
#pragma unroll
    for (int qb = 0; qb < NQB; ++qb)
#pragma unroll
        for (int ks = 0; ks < KS; ++ks) qf[qb][ks] = *(const bf16x8*)(Qb + (size_t)(q0 + 16 * (w * NQB + qb) + fr) * qrs + ks * 32 + fq * 8);
    f32x4 oacc[4][NQB]; float mrun[NQB], lrun[NQB];
#pragma unroll
    for (int qb = 0; qb < NQB; ++qb) { mrun[qb] = 0.f; lrun[qb] = 0.f;
#pragma unroll
        for (int df = 0; df < 4; ++df) oacc[df][qb] = (f32x4){0.f, 0.f, 0.f, 0.f}; }
    u32x4 rk[NKI], rv[2];
    auto gload = [&](int kt) {
#pragma unroll
        for (int i = 0; i < NKI; ++i) { const int c = tid + 512 * i, row = c / CPR, ch = c % CPR; if (kt + row < kt_end) rk[i] = *(const u32x4*)(Kb + (size_t)(kt + row) * krs + ch * 8); }
#pragma unroll
        for (int i = 0; i < 2; ++i) { const int c = tid + 512 * i, row = c >> 3, ch = c & 7; if (kt + row < kt_end) rv[i] = *(const u32x4*)(Vb + (size_t)(kt + row) * vrs + ch * 8); }
    };
    auto sstore = [&](int buf) {
        LAS unsigned char* Kw = smem + buf * STG; LAS unsigned char* Vw = Kw + KT * KP;
#pragma unroll
        for (int i = 0; i < NKI; ++i) { const int c = tid + 512 * i, row = c / CPR, ch = c % CPR; *(LAS u32x4*)(Kw + row * KP + ch * 16) = rk[i]; }
#pragma unroll
        for (int i = 0; i < 2; ++i) { const int c = tid + 512 * i, row = c >> 3, ch = c & 7; *(LAS u32x4*)(Vw + row * VP + ch * 16) = rv[i]; }
    };
#pragma unroll
    for (int i = 0; i < NKI; ++i) rk[i] = (u32x4){0u, 0u, 0u, 0u};
    rv[0] = rv[1] = (u32x4){0u, 0u, 0u, 0u};
    gload(kt_begin); sstore(0); __syncthreads();
    int it = 0;
    for (int kt0 = kt_begin; kt0 < kt_end; kt0 += KT, ++it) {
        const bool more = kt0 + KT < kt_end;
        if (more) gload(kt0 + KT);
#pragma unroll
        for (int sub = 0; sub < KT / 64; ++sub) {
        const int kt = kt0 + 64 * sub;
        if (kt >= kt_end) break;
        const LAS unsigned char* Ks = smem + (it & 1) * STG + sub * 64 * KP; const LAS unsigned char* Vs = smem + (it & 1) * STG + KT * KP + sub * 64 * VP;
        bool run = true;
        if (BAND) { const int qb0 = q0 + 16 * w; run = (kt >= qb0 - 112) && (kt <= qb0 + 64); }
        if (run) {
            f32x4 sacc[4][NQB];
            bf16x8 kfr[4][KS];
#pragma unroll
            for (int kf = 0; kf < 4; ++kf)
#pragma unroll
                for (int ks = 0; ks < KS; ++ks) kfr[kf][ks] = *(const LAS bf16x8*)(Ks + (16 * kf + fr) * KP + ks * 64 + fq * 16);
            __builtin_amdgcn_sched_barrier(0);
            __builtin_amdgcn_s_setprio(1);
#pragma unroll
            for (int kf = 0; kf < 4; ++kf) {
#pragma unroll
                for (int qb = 0; qb < NQB; ++qb) { const float nm = -mrun[qb]; sacc[kf][qb] = (f32x4){nm, nm, nm, nm}; }
#pragma unroll
                for (int ks = 0; ks < KS; ++ks)
#pragma unroll
                    for (int qb = 0; qb < NQB; ++qb) sacc[kf][qb] = MFMA16(kfr[kf][ks], qf[qb][ks], sacc[kf][qb]);
            }
            __builtin_amdgcn_s_setprio(0);
            bf16x8 pf[NQB][2];
#pragma unroll
            for (int qb = 0; qb < NQB; ++qb) {
                if (BAND) { const int qpos = q0 + 16 * (w * NQB + qb) + fr;
#pragma unroll
                    for (int kf = 0; kf < 4; ++kf)
#pragma unroll
                        for (int r = 0; r < 4; ++r) { const int dlt = qpos - (kt + 16 * kf + 4 * fq + r); if (dlt > 64 || dlt < -64) sacc[kf][qb][r] = -1e30f; } }
                float ps = 0.f; unsigned pw[4][2];
#pragma unroll
                for (int kf = 0; kf < 4; ++kf) { const float p0 = fexp2(sacc[kf][qb][0]), p1 = fexp2(sacc[kf][qb][1]), p2 = fexp2(sacc[kf][qb][2]), p3 = fexp2(sacc[kf][qb][3]);
                    ps = (((ps + p0) + p1) + p2) + p3;
                    pw[kf][0] = pack2(p0, p1); pw[kf][1] = pack2(p2, p3); }
                if (!__all(ps <= ATT_PMAX)) {
                    float mx = -1e30f;
#pragma unroll
                    for (int kf = 0; kf < 4; ++kf) mx = fmaxf(mx, fmaxf(fmaxf(sacc[kf][qb][0], sacc[kf][qb][1]), fmaxf(sacc[kf][qb][2], sacc[kf][qb][3])));
                    mx = fmaxf(mx, __shfl_xor(mx, 16)); mx = fmaxf(mx, __shfl_xor(mx, 32));
                    const float delta = fmaxf(mx, 0.f), alpha = fexp2(-delta);
                    mrun[qb] += delta; lrun[qb] *= alpha;
#pragma unroll
                    for (int df = 0; df < 4; ++df) oacc[df][qb] = oacc[df][qb] * alpha;
                    ps = 0.f;
#pragma unroll
                    for (int kf = 0; kf < 4; ++kf) { const float p0 = fexp2(sacc[kf][qb][0] - delta), p1 = fexp2(sacc[kf][qb][1] - delta), p2 = fexp2(sacc[kf][qb][2] - delta), p3 = fexp2(sacc[kf][qb][3] - delta);
                        ps += (p0 + p1) + (p2 + p3); pw[kf][0] = pack2(p0, p1); pw[kf][1] = pack2(p2, p3); }
                }
                lrun[qb] += ps;
#pragma unroll
                for (int c = 0; c < 2; ++c) { const u32x4 t4 = (u32x4){pw[2 * c][0], pw[2 * c][1], pw[2 * c + 1][0], pw[2 * c + 1][1]}; pf[qb][c] = *(const bf16x8*)&t4; }
            }
            __builtin_amdgcn_s_setprio(1);
#pragma unroll
            for (int c = 0; c < 2; ++c)
#pragma unroll
                for (int df = 0; df < 4; ++df) {
                    const LAS unsigned char* vp = Vs + (32 * c + 4 * fq + (fr >> 2)) * VP + (16 * df + 4 * (fr & 3)) * 2;
                    const v4i16_t lo = vtr(vp), hi = vtr(vp + 16 * VP);
                    const bf16x8 vfr = (bf16x8){lo[0], lo[1], lo[2], lo[3], hi[0], hi[1], hi[2], hi[3]};
#pragma unroll
                    for (int qb = 0; qb < NQB; ++qb) oacc[df][qb] = MFMA16(vfr, pf[qb][c], oacc[df][qb]);
                }
            __builtin_amdgcn_s_setprio(0);
        }
        }
        if (more) sstore((it + 1) & 1);
        __syncthreads();
    }
#pragma unroll
    for (int qb = 0; qb < NQB; ++qb) {
        const float l = quad_sum(lrun[qb]), il = 1.0f / l; const int qi = q0 + 16 * (w * NQB + qb) + fr; float ss = 0.f;
#pragma unroll
        for (int df = 0; df < 4; ++df) { const f32x4 v = oacc[df][qb] * il; ss += v[0] * v[0] + v[1] * v[1] + v[2] * v[2] + v[3] * v[3]; *(u32x2*)(Ob + (size_t)qi * ors + 16 * df + 4 * fq) = pack4(v); }
        if (BAND) { if (fq == 0) statb[(size_t)qi * srs] = mrun[qb] + log2f(l); }
        else { ss = quad_sum(ss); if (fq == 0) statb[(size_t)qi * srs] = ss; }
    }
}
constexpr int N_MLA_ITEMS = 512, N_DIL_ITEMS = 3072;
__device__ __forceinline__ void attn_dispatch(const Params& P, int item, LAS unsigned char* smem, int tid) {
    bf16_t* omla = (bf16_t*)P.out; bf16_t* opart = (bf16_t*)P.out + (size_t)T_ * 512;
    if (item < N_MLA_ITEMS) {
        const int bh = item >> 3, qt = item & 7, b = bh >> 3, h = bh & 7;
        attn_item<96, 2, false>(wsp<bf16_t>(P, O_QM) + (size_t)bh * S_ * 96, 96, wsp<bf16_t>(P, O_KM) + (size_t)bh * S_ * 96, 96, wsp<bf16_t>(P, O_VM) + (size_t)bh * S_ * 64, 64,
                                qt * 256, 0, S_, smem, tid, omla + (size_t)b * S_ * 512 + h * 64, 512, wsp<float>(P, O_SSMLA) + (size_t)b * S_ * 8 + h, 8);
    } else {
        const int it = item - N_MLA_ITEMS, p = it >> 10, rem = it & 1023, bh = rem >> 4, qt = rem & 15, b = bh >> 3, h = bh & 7;
        const int dil = dil_of(p), L = S_ / dil, tpr = L >> 7, res = qt / tpr, j0 = (qt - res * tpr) * 128;
        const int kb = j0 - 64 < 0 ? 0 : j0 - 64, ke = j0 + 192 > L ? L : j0 + 192;
        attn_item<64, 1, true>(wsp<bf16_t>(P, O_QD) + ((size_t)bh * S_ + res) * 64, dil * 64, wsp<bf16_t>(P, O_KD) + ((size_t)bh * S_ + res) * 64, dil * 64,
                               wsp<bf16_t>(P, O_VD) + ((size_t)bh * S_ + res) * 64, dil * 64,
                               j0, kb, ke, smem, tid, opart + (size_t)p * T_ * 512 + ((size_t)b * S_ + res) * 512 + h * 64, dil * 512,
                               wsp<float>(P, O_LSE) + ((size_t)p * T_ + (size_t)b * S_ + res) * 8 + h, dil * 8);
    }
}

__device__ __forceinline__ void merge_rows(const Params& P, const bf16_t* omla, const bf16_t* opart, long gwave, long gwaves, int lane, long tend = T_, long tstride = 0) {
    if (tstride == 0) tstride = gwaves;
    for (long t = gwave; t < tend; t += tstride) {
        const int h = lane >> 3;
        const float* lse = wsp<float>(P, O_LSE);
        const float l0 = lse[((size_t)0 * T_ + t) * 8 + h], l1 = lse[((size_t)1 * T_ + t) * 8 + h], l2 = lse[((size_t)2 * T_ + t) * 8 + h];
        const float mx = fmaxf(l0, fmaxf(l1, l2)); float w0 = exp2f(l0 - mx), w1 = exp2f(l1 - mx), w2 = exp2f(l2 - mx); const float iw = 1.0f / (w0 + w1 + w2); w0 *= iw; w1 *= iw; w2 *= iw;
        const u32x4 a0 = *(const u32x4*)(opart + (size_t)0 * T_ * 512 + (size_t)t * 512 + lane * 8), a1 = *(const u32x4*)(opart + (size_t)1 * T_ * 512 + (size_t)t * 512 + lane * 8),
                    a2 = *(const u32x4*)(opart + (size_t)2 * T_ * 512 + (size_t)t * 512 + lane * 8);
        float od[8]; float ssd = 0.f;
#pragma unroll
        for (int j = 0; j < 4; ++j) { od[2 * j] = w0 * bflo(a0[j]) + w1 * bflo(a1[j]) + w2 * bflo(a2[j]); od[2 * j + 1] = w0 * bfhi(a0[j]) + w1 * bfhi(a1[j]) + w2 * bfhi(a2[j]);
            ssd += od[2 * j] * od[2 * j] + od[2 * j + 1] * od[2 * j + 1]; }
        ssd = wave_sum(ssd); const float rd = rsqrtf(ssd * (1.0f / 512.0f) + EPS_);
        const float rm = rstd_from(wsp<float>(P, O_SSMLA) + (size_t)t * 8, 8, 1.0f / 512.0f);
        const u32x4 am = *(const u32x4*)(omla + (size_t)t * 512 + lane * 8);
        bf16_t* mx_ = wsp<bf16_t>(P, O_MIXED) + (size_t)t * D_;
        *(u32x4*)(mx_ + lane * 8) = (u32x4){pack2(bflo(am[0]) * rm, bfhi(am[0]) * rm), pack2(bflo(am[1]) * rm, bfhi(am[1]) * rm), pack2(bflo(am[2]) * rm, bfhi(am[2]) * rm), pack2(bflo(am[3]) * rm, bfhi(am[3]) * rm)};
        *(u32x4*)(mx_ + 512 + lane * 8) = (u32x4){pack2(od[0] * rd, od[1] * rd), pack2(od[2] * rd, od[3] * rd), pack2(od[4] * rd, od[5] * rd), pack2(od[6] * rd, od[7] * rd)};
    }
}
__device__ __forceinline__ void final_rows(const Params& P, long gwave, long gwaves, int lane, long tend = T_, long tstride = 0) {
    if (tstride == 0) tstride = gwaves;
    for (long t = gwave; t < tend; t += tstride) {
        const float rs = rstd_from(wsp<float>(P, O_SSQ3) + (size_t)t * 32, 32, 1.0f / 1024.0f);
        float* o = P.out + (size_t)t * D_;
#pragma unroll
        for (int i = 0; i < 4; ++i) { f32x4 v = *(f32x4*)(o + i * 256 + lane * 4); const f32x4 g = *(const f32x4*)(P.g_final + i * 256 + lane * 4);
            v[0] *= rs * g[0]; v[1] *= rs * g[1]; v[2] *= rs * g[2]; v[3] *= rs * g[3]; *(f32x4*)(o + i * 256 + lane * 4) = v; }
    }
}
__device__ __forceinline__ float wave_max(float v) {
    v = fmaxf(v, DPP_F(v, 0xB1)); v = fmaxf(v, DPP_F(v, 0x4E)); v = fmaxf(v, DPP_F(v, 0x141)); v = fmaxf(v, DPP_F(v, 0x140));
    v = fmaxf(v, __shfl_xor(v, 16)); v = fmaxf(v, __shfl_xor(v, 32));
    return v;
}
__device__ __forceinline__ unsigned q8(float v, float inv, int off) { return (unsigned)((int)rintf(v * inv) + off) & 0xffu; }
__device__ __forceinline__ void prep_tables_q(const Params& P, long gwave, long gwaves, int lane) {
    f32x4 gf[4];
#pragma unroll
    for (int i = 0; i < 4; ++i) gf[i] = *(const f32x4*)(P.g_ffn + lane * 16 + 4 * i);
    for (long r0 = gwave; r0 < 32768; r0 += 2 * gwaves) {
        f32x4 a[2][4];
#pragma unroll
        for (int u = 0; u < 2; ++u) { const long r = (r0 + u * gwaves < 32768) ? r0 + u * gwaves : r0; const bool isv = r >= 16384; const int e = (int)(r & 16383);
            const float* src = (isv ? P.peer_v : P.peer_u) + (size_t)e * D_ + lane * 16;
#pragma unroll
            for (int i = 0; i < 4; ++i) a[u][i] = *(const f32x4*)(src + 4 * i); }
#pragma unroll
        for (int u = 0; u < 2; ++u) { const long r = r0 + u * gwaves;
            if (r < 32768) {
                const bool isv = r >= 16384; const int e = (int)(r & 16383); float am = 0.f;
#pragma unroll
                for (int i = 0; i < 4; ++i) { if (!isv) a[u][i] = a[u][i] * gf[i]; am = fmaxf(am, fmaxf(fmaxf(fabsf(a[u][i][0]), fabsf(a[u][i][1])), fmaxf(fabsf(a[u][i][2]), fabsf(a[u][i][3])))); }
                am = wave_max(am);
                const float inv = am > 0.f ? 127.0f / am : 0.f; const int off = 0;
                u32x4 w;
#pragma unroll
                for (int i = 0; i < 4; ++i) w[i] = q8(a[u][i][0], inv, off) | (q8(a[u][i][1], inv, off) << 8) | (q8(a[u][i][2], inv, off) << 16) | (q8(a[u][i][3], inv, off) << 24);
                *(u32x4*)(P.ws + (isv ? O_VQ : O_UQ) + ((size_t)(lane >> 3) * 16384 + e) * 128 + (lane & 7) * 16) = w;
                if (lane == 0) wsp<float>(P, isv ? O_VS : O_US)[e] = am * (1.0f / 127.0f);
            } }
    }
}
__device__ __forceinline__ void p6_xq(const Params& P, int pm, int pn, int tid) {
    const int sub = tid & 15, tr = tid >> 4;
#pragma unroll 2
    for (int it = 0; it < 8; ++it) {
        const int t = pm * 256 + it * 32 + tr;
        const bf16_t* hp = wsp<bf16_t>(P, O_HG) + (size_t)t * D_ + pn * 256 + sub * 16;
        const u32x4 h0 = *(const u32x4*)hp, h1 = *(const u32x4*)(hp + 8);
        const float inv = wsp<float>(P, O_RSTDH)[t] * (127.0f * 256.0f / (5.5f * 32767.0f)), c = 128.0f / 32767.0f;
        float xv[16];
#pragma unroll
        for (int q = 0; q < 4; ++q) { xv[2 * q] = bflo(h0[q]); xv[2 * q + 1] = bfhi(h0[q]); xv[8 + 2 * q] = bflo(h1[q]); xv[8 + 2 * q + 1] = bfhi(h1[q]); }
        u32x4 xq;
#pragma unroll
        for (int q = 0; q < 4; ++q) { const unsigned w0 = __builtin_bit_cast(unsigned, __builtin_amdgcn_cvt_pknorm_i16(fmaf(xv[4 * q], inv, c), fmaf(xv[4 * q + 1], inv, c)));
            const unsigned w1 = __builtin_bit_cast(unsigned, __builtin_amdgcn_cvt_pknorm_i16(fmaf(xv[4 * q + 2], inv, c), fmaf(xv[4 * q + 3], inv, c)));
            xq[q] = __builtin_amdgcn_perm(w1, w0, 0x07050301u); }
        *(u32x4*)(P.ws + O_XQ + (size_t)t * D_ + pn * 256 + sub * 16) = xq;
    }
}
struct P7aMeta { u32x4 id0, id1, xq; float rs; };
__device__ __forceinline__ unsigned rowoff(const u32x4& a, const u32x4& b, int i, unsigned j16) {
    const unsigned w = (i < 8) ? a[(i >> 1) & 3] : b[(i >> 1) & 3]; unsigned r;
    if (i & 1) asm("v_mad_u32_u16 %0, %1, %2, %3 op_sel:[1,0,0,0]" : "=v"(r) : "v"(w), "s"(128u), "v"(j16));
    else       asm("v_mad_u32_u16 %0, %1, %2, %3 op_sel:[0,0,0,0]" : "=v"(r) : "v"(w), "s"(128u), "v"(j16));
    return r; }
__device__ __forceinline__ int dot4z(unsigned a, unsigned b) { int d; asm("v_dot4_i32_i8 %0, %1, %2, 0" : "=v"(d) : "v"(a), "v"(b)); return d; }
__device__ __forceinline__ unsigned id16(const u32x4& a, const u32x4& b, int i) { const unsigned w = (i < 8) ? a[(i >> 1) & 3] : b[(i >> 1) & 3]; return (i & 1) ? (w >> 16) : (w & 0xffffu); }
__device__ __forceinline__ void p7a_loop(const Params& P, int xs, int lane, int t0, int tstride) {
    const int g = lane >> 3, j = lane & 7;
    const unsigned char* UQ = P.ws + O_UQ + (size_t)xs * 16384 * 128; const unsigned j16 = (unsigned)j * 16u;
    auto META = [&](int t, P7aMeta& m) {
        const unsigned short* ip = wsp<unsigned short>(P, O_EIDX) + (size_t)t * 128 + g * 16; m.id0 = *(const u32x4*)ip; m.id1 = *(const u32x4*)(ip + 8);
        m.xq = *(const u32x4*)(P.ws + O_XQ + (size_t)t * D_ + xs * 128 + j * 16); m.rs = wsp<float>(P, O_RSTDH)[t]; };
    auto ISSUE = [&](const P7aMeta& m, u32x4 (&rows)[16]) {
#pragma unroll
        for (int i = 0; i < 16; ++i) rows[i] = *(const u32x4*)(UQ + rowoff(m.id0, m.id1, i, j16)); };
    auto COMPUTE = [&](int t, const P7aMeta& m, const u32x4 (&rows)[16]) {
        const float sx = (5.5f / 127.0f) / m.rs;
        int acc[16];
#pragma unroll
        for (int i = 0; i < 16; ++i) { int d = dot4z(rows[i][0], m.xq[0]); d = __builtin_amdgcn_sdot4((int)rows[i][1], (int)m.xq[1], d, false);
            d = __builtin_amdgcn_sdot4((int)rows[i][2], (int)m.xq[2], d, false); acc[i] = __builtin_amdgcn_sdot4((int)rows[i][3], (int)m.xq[3], d, false); }
        int b8[8], c4[4], d2[2];
        { const bool hi = (j & 4) != 0;
#pragma unroll
          for (int m2 = 0; m2 < 8; ++m2) { const int send = hi ? acc[m2] : acc[m2 + 8], keep = hi ? acc[m2 + 8] : acc[m2]; b8[m2] = keep + DPP_I(send, 0x141); } }
        { const bool hi = (j & 2) != 0;
#pragma unroll
          for (int m2 = 0; m2 < 4; ++m2) { const int send = hi ? b8[m2] : b8[m2 + 4], keep = hi ? b8[m2 + 4] : b8[m2]; c4[m2] = keep + DPP_I(send, 0x4E); } }
        { const bool hi = (j & 1) != 0;
#pragma unroll
          for (int m2 = 0; m2 < 2; ++m2) { const int send = hi ? c4[m2] : c4[m2 + 2], keep = hi ? c4[m2 + 2] : c4[m2]; d2[m2] = keep + DPP_I(send, 0xB1); } }
        bf16_t* part = (bf16_t*)P.out + ((size_t)xs * T_ + t) * 128;
#pragma unroll
        for (int m2 = 0; m2 < 2; ++m2) part[16 * j + 8 * m2 + g] = f2bf((float)d2[m2] * sx); };
    P7aMeta mA, mB, mC; mA.id0 = mA.id1 = mA.xq = (u32x4){0u, 0u, 0u, 0u}; mA.rs = 1.f; mB = mA; mC = mA;
    u32x4 rA[16], rB[16];
    int t = t0;
    auto TCL = [&](int tt) { return tt < T_ ? tt : t0; };
    META(TCL(t), mA);
    META(TCL(t + tstride), mB);
    ISSUE(mA, rA);
    while (t < T_) {
        META(TCL(t + 2 * tstride), mC);
        ISSUE(mB, rB);
        COMPUTE(t, mA, rA);
        t += tstride; if (t >= T_) break;
        META(TCL(t + 2 * tstride), mA);
        ISSUE(mC, rA);
        COMPUTE(t, mB, rB);
        t += tstride; if (t >= T_) break;
        META(TCL(t + 2 * tstride), mB);
        ISSUE(mA, rB);
        COMPUTE(t, mC, rA);
        t += tstride; if (t >= T_) break;
        META(TCL(t + 2 * tstride), mC);
        ISSUE(mB, rA);
        COMPUTE(t, mA, rB);
        t += tstride; if (t >= T_) break;
        META(TCL(t + 2 * tstride), mA);
        ISSUE(mC, rB);
        COMPUTE(t, mB, rA);
        t += tstride; if (t >= T_) break;
        META(TCL(t + 2 * tstride), mB);
        ISSUE(mA, rA);
        COMPUTE(t, mC, rB);
        t += tstride;
    }
}
__device__ __forceinline__ void p7b_loop(const Params& P, int t0, int tstride, int lane) {
    for (int tb = t0; tb < T_; tb += 2 * tstride) {
        float rs[2], s[2][2], gt[2][2], us[2][2], vs[2][2]; int e[2][2];
#pragma unroll
        for (int u = 0; u < 2; ++u) { const int t = (tb + u * tstride < T_) ? tb + u * tstride : tb; rs[u] = wsp<float>(P, O_RSTDH)[t];
#pragma unroll
            for (int hf = 0; hf < 2; ++hf) { const int k = lane + 64 * hf; float a = 0.f;
#pragma unroll
                for (int x = 0; x < 8; ++x) a += bf2f(((const bf16_t*)P.out)[((size_t)x * T_ + t) * 128 + k]);
                s[u][hf] = a; e[u][hf] = wsp<unsigned short>(P, O_EIDX)[(size_t)t * 128 + (k & 7) * 16 + (k >> 3)]; gt[u][hf] = wsp<float>(P, O_GATE)[(size_t)t * 128 + k]; } }
#pragma unroll
        for (int u = 0; u < 2; ++u)
#pragma unroll
            for (int hf = 0; hf < 2; ++hf) { us[u][hf] = wsp<float>(P, O_US)[e[u][hf]]; vs[u][hf] = wsp<float>(P, O_VS)[e[u][hf]]; }
        asm volatile("s_waitcnt vmcnt(0)" ::: "memory");
#pragma unroll
        for (int u = 0; u < 2; ++u) { const int t = tb + u * tstride;
            if (t < T_) {
                float cf[2];
#pragma unroll
                for (int hf = 0; hf < 2; ++hf) { const float a = rs[u] * s[u][hf] * us[u][hf]; cf[hf] = gt[u][hf] * 0.5f * a * (1.0f + erff(a * 0.70710678118654752f)) * vs[u][hf]; }
                const float cmax = wave_max(fmaxf(fabsf(cf[0]), fabsf(cf[1])));
                const float inv = cmax > 0.f ? 127.0f / cmax : 0.f;
                unsigned char* row = (unsigned char*)(wsp<float>(P, O_GATE) + (size_t)t * 128);
#pragma unroll
                for (int hf = 0; hf < 2; ++hf) { const int k = lane + 64 * hf; row[(k & 7) * 16 + (k >> 3)] = (unsigned char)(q8(cf[hf], inv, 0)); }
                if (lane == 0) *(float*)(row + 128) = cmax * (1.0f / 127.0f);
            } }
    }
}
struct P7cMeta { u32x4 id0, id1, cw; float cs, h0, h1; };
__device__ __forceinline__ void p7c_loop(const Params& P, int xs, int lane, int t0, int tstride) {
    const int g = lane >> 3, j = lane & 7;
    const unsigned char* VQ = P.ws + O_VQ + (size_t)xs * 16384 * 128; const unsigned j16 = (unsigned)j * 16u;
    const int col = xs * 128 + 16 * j + 2 * g;
    auto META = [&](int t, P7cMeta& m) {
        const unsigned short* ip = wsp<unsigned short>(P, O_EIDX) + (size_t)t * 128 + g * 16; m.id0 = *(const u32x4*)ip; m.id1 = *(const u32x4*)(ip + 8);
        const unsigned char* crow = (const unsigned char*)(wsp<float>(P, O_GATE) + (size_t)t * 128); m.cw = *(const u32x4*)(crow + g * 16); m.cs = *(const float*)(crow + 128);
        const unsigned hw = *(const unsigned*)(wsp<bf16_t>(P, O_HG) + (size_t)t * D_ + col); m.h0 = bflo(hw); m.h1 = bfhi(hw); };
    auto ISSUE = [&](const P7cMeta& m, u32x4 (&rows)[16]) {
#pragma unroll
        for (int i = 0; i < 16; ++i) rows[i] = *(const u32x4*)(VQ + rowoff(m.id0, m.id1, i, j16)); };
    auto COMPUTE = [&](int t, const P7cMeta& m, const u32x4 (&rows)[16]) {
        int acc[16];
#pragma unroll
        for (int mg = 0; mg < 4; ++mg)
#pragma unroll
            for (int d = 0; d < 4; ++d) {
                const unsigned R0 = rows[4 * mg][d], R1 = rows[4 * mg + 1][d], R2 = rows[4 * mg + 2][d], R3 = rows[4 * mg + 3][d];
                const unsigned t0 = __builtin_amdgcn_perm(R1, R0, 0x06020400u), t1 = __builtin_amdgcn_perm(R1, R0, 0x07030501u);
                const unsigned t2 = __builtin_amdgcn_perm(R3, R2, 0x06020400u), t3 = __builtin_amdgcn_perm(R3, R2, 0x07030501u);
                const unsigned T0 = __builtin_amdgcn_perm(t2, t0, 0x05040100u), T2 = __builtin_amdgcn_perm(t2, t0, 0x07060302u);
                const unsigned T1 = __builtin_amdgcn_perm(t3, t1, 0x05040100u), T3 = __builtin_amdgcn_perm(t3, t1, 0x07060302u);
                if (mg == 0) { acc[4 * d] = dot4z(T0, m.cw[0]); acc[4 * d + 1] = dot4z(T1, m.cw[0]); acc[4 * d + 2] = dot4z(T2, m.cw[0]); acc[4 * d + 3] = dot4z(T3, m.cw[0]); }
                else { acc[4 * d] = __builtin_amdgcn_sdot4((int)T0, (int)m.cw[mg], acc[4 * d], false); acc[4 * d + 1] = __builtin_amdgcn_sdot4((int)T1, (int)m.cw[mg], acc[4 * d + 1], false);
                       acc[4 * d + 2] = __builtin_amdgcn_sdot4((int)T2, (int)m.cw[mg], acc[4 * d + 2], false); acc[4 * d + 3] = __builtin_amdgcn_sdot4((int)T3, (int)m.cw[mg], acc[4 * d + 3], false); }
            }
        int b8[8], c4[4], d2[2];
#pragma unroll
        for (int q = 0; q < 8; ++q) { const auto r = __builtin_amdgcn_permlane32_swap((unsigned)acc[q], (unsigned)acc[q + 8], false, false); b8[q] = (int)(r[0] + r[1]); }
#pragma unroll
        for (int q = 0; q < 4; ++q) { const auto r = __builtin_amdgcn_permlane16_swap((unsigned)b8[q], (unsigned)b8[q + 4], false, false); c4[q] = (int)(r[0] + r[1]); }
        { const bool hi = (g & 1) != 0;
#pragma unroll
          for (int q = 0; q < 2; ++q) { const int send = hi ? c4[q] : c4[q + 2], keep = hi ? c4[q + 2] : c4[q]; d2[q] = keep + DPP_I(send, 0x128); } }
        const size_t o = (size_t)t * D_ + col;
        const float y0 = m.h0 + (float)d2[0] * m.cs, y1 = m.h1 + (float)d2[1] * m.cs;
        *(unsigned*)(wsp<bf16_t>(P, O_HG) + o) = pack2(y0, y1);
        const float ss = wave_sum(y0 * y0 + y1 * y1);
        if (lane == 0) wsp<float>(P, O_SSQ2)[(size_t)t * 8 + xs] = ss; };
    P7cMeta mA{(u32x4){0u, 0u, 0u, 0u}, (u32x4){0u, 0u, 0u, 0u}, (u32x4){0u, 0u, 0u, 0u}, 0.f, 0.f, 0.f}, mB = mA, mC = mA; u32x4 rA[16], rB[16];
    int t = t0;
    auto TCL = [&](int tt) { return tt < T_ ? tt : t0; };
    META(TCL(t), mA);
    META(TCL(t + tstride), mB);
    ISSUE(mA, rA);
    while (t < T_) {
        META(TCL(t + 2 * tstride), mC);
        ISSUE(mB, rB);
        COMPUTE(t, mA, rA);
        t += tstride; if (t >= T_) break;
        META(TCL(t + 2 * tstride), mA);
        ISSUE(mC, rA);
        COMPUTE(t, mB, rB);
        t += tstride; if (t >= T_) break;
        META(TCL(t + 2 * tstride), mB);
        ISSUE(mA, rB);
        COMPUTE(t, mC, rA);
        t += tstride; if (t >= T_) break;
        META(TCL(t + 2 * tstride), mC);
        ISSUE(mB, rA);
        COMPUTE(t, mA, rB);
        t += tstride; if (t >= T_) break;
        META(TCL(t + 2 * tstride), mA);
        ISSUE(mC, rB);
        COMPUTE(t, mB, rA);
        t += tstride; if (t >= T_) break;
        META(TCL(t + 2 * tstride), mB);
        ISSUE(mA, rA);
        COMPUTE(t, mC, rB);
        t += tstride;
    }
}

__global__ void __launch_bounds__(NTHR, 2) k_mega(Params P) {
    extern __shared__ __attribute__((aligned(16))) unsigned char smem_[];
    LAS unsigned char* lds = (LAS unsigned char*)smem_;
    const int tid = threadIdx.x, lane = tid & 63, wv = __builtin_amdgcn_readfirstlane(tid >> 6);
    const int G = gridDim.x, bid = blockIdx.x, xg = bid & 7, lb = bid >> 3, nlb = G >> 3;
    volatile LAS unsigned* st = (volatile LAS unsigned*)(lds + LDS_CTL);
    if (tid == 0) { st[0] = 0u; st[1] = 0u; st[2] = 0u; st[3] = 0u; }
    __syncthreads();
    XcdBarrier xb = xcd_barrier_post((unsigned*)(P.ws + O_BAR), st); unsigned bepoch = 0u;
    const long rw0 = (long)xg * 2048 + lb * NWAVE + wv, rwe = (long)xg * 2048 + 2048; const int rws = nlb * NWAVE;
    if (PH(0)) for (int rep = 0; rep < REP_P0; ++rep) {
    prep_weights(P, (long)bid * NTHR + tid, (long)G * NTHR); prep_weights_late(P, (long)bid * NTHR + tid, (long)G * NTHR);
    prep_rows(P, rw0, 0, opq_v(lane), rwe, rws); }
    xcd_barrier(xb, bepoch);
    if (PH(1)) for (int rep = 0; rep < REP_P1; ++rep)
    { pg8::Gemm g{wsp<bf16_t>(P, O_XB), wsp<bf16_t>(P, O_WIN), T_, NIN, opaque(D_)}; XSched S{xg, lb, nlb, NIN / 256}; Epi1 E{P};
      pg8::gemm_phase<Epi1, XSched, true, true>(lds, g, S, E);
      if (nlb == 32) { if (lb >= 8) prep_tables_q(P, (long)((xg * 24 + (lb - 8)) * NWAVE + wv), 192L * NWAVE, opq_v(lane)); }
      else prep_tables_q(P, (long)bid * NWAVE + wv, (long)G * NWAVE, opq_v(lane)); }
    xcd_barrier(xb, bepoch);
    if (PH(2)) for (int rep = 0; rep < REP_P2; ++rep) {
    { XSched S{xg, lb, nlb, 4}; pg8::Unit u; for (int i = 0; S.next(i, u); ++i) { if (tid < 256) rows_rstd(wsp<float>(P, O_SSQQ), 12, 1.0f / 384.0f, wsp<float>(P, O_RSTDQ), u.pm, tid);
          else rows_rstd(wsp<float>(P, O_SSQKV), 8, 1.0f / 256.0f, wsp<float>(P, O_RSTDKV), u.pm, tid - 256); } }
    { XSched S{xg, lb, nlb, 3}; pg8::Unit u; for (int i = 0; S.next(i, u); ++i) { if (tid < 256) rows_rstd(wsp<float>(P, O_SSQQ), 12, 1.0f / 384.0f, wsp<float>(P, O_RSTDQ), u.pm, tid); } }
    WG_PUBLISH();
    { pg8::Gemm g{wsp<bf16_t>(P, O_CQ), wsp<bf16_t>(P, O_WUQ), T_, 768, opaque(384)}; XSched S{xg, lb, nlb, 3}; Epi2a E{P};
      pg8::gemm_phase<Epi2a, XSched, true, true>(lds, g, S, E); }
    { pg8::Gemm g{wsp<bf16_t>(P, O_CKV), wsp<bf16_t>(P, O_WUKV), T_, 1024, opaque(256)}; XSched S{xg, lb, nlb, 4}; Epi2b E{P};
      pg8::gemm_phase<Epi2b, XSched, true, true>(lds, g, S, E); } }
    xcd_barrier(xb, bepoch);
    if (PH(3)) for (int rep = 0; rep < REP_P3; ++rep)
    for (int j = lb; j < 64 + 384; j += nlb) {
        int item;
        if (j < 64) item = (xg * 8 + (j >> 3)) * 8 + (j & 7);
        else { const int jj = j - 64, p = jj >> 7, r = jj & 127; item = N_MLA_ITEMS + p * 1024 + (xg * 8 + (r >> 4)) * 16 + (r & 15); }
        attn_dispatch(P, item, lds, opq_v(tid)); __syncthreads();
    }
    xcd_barrier(xb, bepoch);
    if (PH(4)) for (int rep = 0; rep < REP_P4; ++rep) {
    { const int ln = opq_v(lane); merge_rows(P, (const bf16_t*)P.out, (const bf16_t*)P.out + (size_t)T_ * 512, rw0, 0, ln, rwe, rws);
    } }
    xcd_barrier(xb, bepoch);
    if (PH(5)) for (int rep = 0; rep < REP_P5; ++rep)
    { pg8::Gemm g{wsp<bf16_t>(P, O_MIXED), wsp<bf16_t>(P, O_WOUT), T_, D_, opaque(D_)}; XSched S{xg, lb, nlb, 4}; Epi5 E{P};
      pg8::gemm_phase<Epi5, XSched, true, true>(lds, g, S, E); }
    xcd_barrier(xb, bepoch);
    if (PH(6)) for (int rep = 0; rep < REP_P6; ++rep) {
    { XSched S{xg, lb, nlb, 4}; pg8::Unit u; for (int i = 0; S.next(i, u); ++i) if (tid < 256) rows_rstd(wsp<float>(P, O_SSQH), 32, 1.0f / 1024.0f, wsp<float>(P, O_RSTDH), u.pm, tid); }
    WG_PUBLISH();
    { pg8::Gemm g{wsp<bf16_t>(P, O_HG), wsp<bf16_t>(P, O_WPQ), T_, D_, opaque(D_)}; XSched S{xg, lb, nlb, 4}; Epi6q E{P};
      pg8::gemm_phase<Epi6q, XSched, true, true>(lds, g, S, E); }
    WG_PUBLISH();
    { XSched S{xg, lb, nlb, 4}; pg8::Unit u; for (int i = 0; S.next(i, u); ++i) p6_topk(P, u.pm, u.pn, lds, opq_v(tid)); }
    { XSched S{xg, lb, nlb, 4}; pg8::Unit u; for (int i = 0; S.next(i, u); ++i) p6_xq(P, u.pm, u.pn, opq_v(tid)); } }
    xcd_barrier(xb, bepoch);
    if (PH(7)) for (int rep = 0; rep < REP_P7; ++rep)
    p7a_loop(P, xg, opq_v(lane), lb * NWAVE + wv, nlb * NWAVE);
    xcd_barrier(xb, bepoch);
    if (PH(7)) p7b_loop(P, bid * NWAVE + wv, G * NWAVE, opq_v(lane));
    xcd_barrier(xb, bepoch);
    if (PH(7)) p7c_loop(P, xg, opq_v(lane), lb * NWAVE + wv, nlb * NWAVE);
    xcd_barrier(xb, bepoch);
    if (PH(8)) for (int rep = 0; rep < REP_P8; ++rep) {
    { XSched S{xg, lb, nlb, 4}; pg8::Unit u; for (int i = 0; S.next(i, u); ++i) if (tid < 256) rows_rstd(wsp<float>(P, O_SSQ2), 8, 1.0f / 1024.0f, wsp<float>(P, O_RSTD2), u.pm, tid); }
    WG_PUBLISH();
    { pg8::Gemm g{wsp<bf16_t>(P, O_HG), wsp<bf16_t>(P, O_WPG), T_, D_, opaque(D_)}; XSched S{xg, lb, nlb, 4}; Epi8a E{P};
      pg8::gemm_phase<Epi8a, XSched, true, true>(lds, g, S, E); }
    { pg8::Gemm g{wsp<bf16_t>(P, O_PB), wsp<bf16_t>(P, O_WPP), T_, D_, opaque(256)}; XSched S{xg, lb, nlb, 4}; Epi8b E{P};
      pg8::gemm_phase<Epi8b, XSched, false, true>(lds, g, S, E); } }
}

extern "C" void kernel_launch(void* const* d_in, const int* in_sizes, int n_in, void* d_out, int out_size, void* d_ws, size_t ws_size, hipStream_t stream) {
    if (ws_size < WS_NEED) { fprintf(stderr, "workspace too small: %zu < %zu\n", ws_size, (size_t)WS_NEED); return; }
    Params P{};
    const float** f = (const float**)&P;
    for (int i = 0; i < 21; ++i) f[i] = (const float*)d_in[i];
    P.out = (float*)d_out; P.ws = (unsigned char*)d_ws;
    static int grid_blocks = 0;
    if (!grid_blocks) {
        int dev = 0, cus = 0, per_cu = 0;
        hipGetDevice(&dev);
        hipDeviceGetAttribute(&cus, hipDeviceAttributeMultiprocessorCount, dev);
        hipFuncSetAttribute((const void*)k_mega, hipFuncAttributeMaxDynamicSharedMemorySize, LDS_BYTES);
        hipOccupancyMaxActiveBlocksPerMultiprocessor(&per_cu, k_mega, NTHR, LDS_BYTES);
        if (per_cu < 1) { fprintf(stderr, "occupancy query says %d blocks per CU\n", per_cu); per_cu = 1; }
        grid_blocks = cus;
        if (grid_blocks != 256) { fprintf(stderr, "this kernel is built for a 256-CU device (got %d CUs); launching 256 workgroups\n", cus); grid_blocks = 256; }
    }
    hipMemsetAsync(d_ws, 0, 32768, stream);
    void* args[] = {&P};
    hipError_t e = hipLaunchCooperativeKernel((void*)k_mega, dim3(grid_blocks), dim3(NTHR), args, LDS_BYTES, stream);
    if (e != hipSuccess) fprintf(stderr, "cooperative launch failed: %s (grid %d)\n", hipGetErrorString(e), grid_blocks);
}
```
